# Optimizing an MI355X kernel written in HIP

```python
import math
import jax, jax.numpy as jnp
from jax import lax
import numpy as np

D_MODEL = 1024
BATCH = 2
SEQ = 8192
DEPTH = 1

CHUNK = 64
D_SSM = D_MODEL // 2
SSM_GROUP = 16
N_SSM_GROUPS = D_SSM // SSM_GROUP
SSM_STATE = 64
D_RWKV = D_MODEL // 2
RWKV_HEAD = 64
N_RWKV_HEADS = D_RWKV // RWKV_HEAD
DECAY_LORA = 64
AAA_LORA = 64
GATE_LORA = 128
D_RWKV_IN = 3 * D_RWKV + GATE_LORA + DECAY_LORA + AAA_LORA
D_IN = D_SSM + D_RWKV_IN + 2 * D_MODEL
D_FF = 4 * D_MODEL
RMS_EPS = 1e-6
GN_EPS = 64e-5
L2_EPS = 1e-12
MIN_NEG_REAL = -1e-4

kernel_name = "hybrid_s5_rwkv7_gated_block"


def rmsnorm(x, g):
    xf = x.astype(jnp.float32)
    y = xf * lax.rsqrt(jnp.mean(xf * xf, axis=-1, keepdims=True) + RMS_EPS)
    return (y * g.astype(jnp.float32)).astype(x.dtype)


def s5_branch(u, lam_re, lam_im, log_dt, b_re, b_im, c_re, c_im, d_skip, w_glu, b_glu):
    bsz, seq, _ = u.shape
    uf = u.astype(jnp.float32).reshape(bsz, seq, N_SSM_GROUPS, SSM_GROUP)
    lr = jnp.minimum(lam_re.astype(jnp.float32), MIN_NEG_REAL)
    li = lam_im.astype(jnp.float32)
    dt = jnp.exp(log_dt.astype(jnp.float32))[:, None]
    mag = jnp.exp(lr * dt)
    ab_re = mag * jnp.cos(li * dt)
    ab_im = mag * jnp.sin(li * dt)
    den = lr * lr + li * li
    xm1 = ab_re - 1.0
    q_re = (xm1 * lr + ab_im * li) / den
    q_im = (ab_im * lr - xm1 * li) / den
    br = b_re.astype(jnp.float32)
    bi = b_im.astype(jnp.float32)
    bb_re = q_re[..., None] * br - q_im[..., None] * bi
    bb_im = q_re[..., None] * bi + q_im[..., None] * br
    bu_re = jnp.einsum('gpm,bsgm->bsgp', bb_re, uf)
    bu_im = jnp.einsum('gpm,bsgm->bsgp', bb_im, uf)
    a_re = jnp.broadcast_to(ab_re, bu_re.shape)
    a_im = jnp.broadcast_to(ab_im, bu_im.shape)

    def combine(e1, e2):
        a1r, a1i, b1r, b1i = e1
        a2r, a2i, b2r, b2i = e2
        return (a2r * a1r - a2i * a1i,
                a2r * a1i + a2i * a1r,
                a2r * b1r - a2i * b1i + b2r,
                a2r * b1i + a2i * b1r + b2i)

    _, _, xs_re, xs_im = lax.associative_scan(combine, (a_re, a_im, bu_re, bu_im), axis=1)
    y = (jnp.einsum('gmp,bsgp->bsgm', c_re.astype(jnp.float32), xs_re)
         - jnp.einsum('gmp,bsgp->bsgm', c_im.astype(jnp.float32), xs_im)
         + d_skip.astype(jnp.float32).reshape(N_SSM_GROUPS, SSM_GROUP) * uf)
    y = y.reshape(bsz, seq, D_SSM)
    z = jax.nn.gelu(y)
    out = z * jax.nn.sigmoid(z @ w_glu.astype(jnp.float32) + b_glu.astype(jnp.float32))
    return out.astype(u.dtype)


def rwkv7_branch(p, mu, w0, w2, a0, a2, g2, k_k, k_a, r_k, lnx_g, lnx_b):
    bsz, seq, _ = p.shape
    pf = p.astype(jnp.float32)
    prev = jnp.pad(pf[:, :-1], ((0, 0), (1, 0), (0, 0)))
    pm = pf + (prev - pf) * mu.astype(jnp.float32)
    o1 = D_RWKV
    o2 = 2 * D_RWKV
    o3 = 3 * D_RWKV
    o4 = o3 + GATE_LORA
    o5 = o4 + DECAY_LORA
    r = pm[..., :o1]
    k = pm[..., o1:o2]
    v = pm[..., o2:o3]
    xg = pm[..., o3:o4]
    xw = pm[..., o4:o5]
    xa = pm[..., o5:]
    w = -jax.nn.softplus(-(w0 + jnp.tanh(xw) @ w2.astype(jnp.float32))) - 0.5
    decay = jnp.exp(-jnp.exp(w))
    a = jax.nn.sigmoid(a0 + xa @ a2.astype(jnp.float32))
    g = jax.nn.sigmoid(xg) @ g2.astype(jnp.float32)

    hs = (bsz, seq, N_RWKV_HEADS, RWKV_HEAD)
    r = r.reshape(hs)
    k = k.reshape(hs)
    v = v.reshape(hs)
    decay = decay.reshape(hs)
    a = a.reshape(hs)
    kk = k * k_k.astype(jnp.float32).reshape(N_RWKV_HEADS, RWKV_HEAD)
    kk = kk / jnp.maximum(jnp.linalg.norm(kk, axis=-1, keepdims=True), L2_EPS)
    k = k * (1.0 + (a - 1.0) * k_a.astype(jnp.float32).reshape(N_RWKV_HEADS, RWKV_HEAD))
    a_vec = -kk
    b_vec = kk * a

    n_chunks = seq // CHUNK

    def to_chunks(t):
        return jnp.transpose(t, (1, 0, 2, 3)).reshape(n_chunks, CHUNK, bsz, N_RWKV_HEADS, RWKV_HEAD)

    def step(state, inp):
        rt, wt, kt, vt, at, bt = inp
        sa = jnp.einsum('bhvk,bhk->bhv', state, at)
        state = (state * wt[:, :, None, :] + sa[..., None] * bt[:, :, None, :]
                 + vt[..., None] * kt[:, :, None, :])
        yt = jnp.einsum('bhvk,bhk->bhv', state, rt)
        return state, yt

    def chunk_step(state, chunk_inp):
        return lax.scan(step, state, chunk_inp)

    state0 = jnp.zeros((bsz, N_RWKV_HEADS, RWKV_HEAD, RWKV_HEAD), jnp.float32)
    xs = tuple(to_chunks(t) for t in (r, decay, k, v, a_vec, b_vec))
    _, ys = lax.scan(chunk_step, state0, xs)
    y = jnp.transpose(ys.reshape(seq, bsz, N_RWKV_HEADS, RWKV_HEAD), (1, 0, 2, 3))

    mean = jnp.mean(y, axis=-1, keepdims=True)
    var = jnp.mean(jnp.square(y - mean), axis=-1, keepdims=True)
    y = (y - mean) * lax.rsqrt(var + GN_EPS)
    y = (y * lnx_g.astype(jnp.float32).reshape(N_RWKV_HEADS, RWKV_HEAD)
         + lnx_b.astype(jnp.float32).reshape(N_RWKV_HEADS, RWKV_HEAD))
    bonus = jnp.sum(r * k * r_k.astype(jnp.float32), axis=-1, keepdims=True) * v
    y = (y + bonus).reshape(bsz, seq, D_RWKV) * g
    return y.astype(p.dtype)


def setup_inputs(seed: int = 0) -> dict:
    key = jax.random.key(seed)
    ks = jax.random.split(key, 32)
    L = DEPTH
    G, P, M = N_SSM_GROUPS, SSM_STATE, SSM_GROUP
    f32 = jnp.float32
    nrm = lambda k, s: jax.random.normal(k, s, f32)
    x = nrm(ks[0], (BATCH, SEQ, D_MODEL))
    norm1_g = 1.0 + 0.02 * nrm(ks[1], (L, D_MODEL))
    w_in = nrm(ks[2], (L, D_MODEL, D_IN)) * D_MODEL ** -0.5
    lam_re = -0.5 + 0.01 * nrm(ks[3], (L, G, P))
    lam_im = math.pi * jnp.arange(P, dtype=f32)[None, None, :] + 0.01 * nrm(ks[4], (L, G, P))
    log_dt = jax.random.uniform(ks[5], (L, G), f32, math.log(1e-3), math.log(1e-1))
    b_re = nrm(ks[6], (L, G, P, M)) * (2.0 * M) ** -0.5
    b_im = nrm(ks[7], (L, G, P, M)) * (2.0 * M) ** -0.5
    c_re = 0.5 * nrm(ks[8], (L, G, M, P))
    c_im = 0.5 * nrm(ks[9], (L, G, M, P))
    d_skip = nrm(ks[10], (L, D_SSM))
    w_glu = nrm(ks[11], (L, D_SSM, D_SSM)) * D_SSM ** -0.5
    b_glu = 0.01 * nrm(ks[12], (L, D_SSM))
    mu_rwkv = jax.random.uniform(ks[13], (L, D_RWKV_IN), f32)
    w0 = jax.random.uniform(ks[14], (L, D_RWKV), f32, -6.5, -1.5)
    w2 = 0.1 * nrm(ks[15], (L, DECAY_LORA, D_RWKV))
    a0 = 0.1 * nrm(ks[16], (L, D_RWKV))
    a2 = 0.1 * nrm(ks[17], (L, AAA_LORA, D_RWKV))
    g2 = nrm(ks[18], (L, GATE_LORA, D_RWKV)) * GATE_LORA ** -0.5
    k_k = 0.85 + 0.02 * nrm(ks[19], (L, D_RWKV))
    k_a = 1.0 + 0.02 * nrm(ks[20], (L, D_RWKV))
    r_k = 0.1 * nrm(ks[21], (L, N_RWKV_HEADS, RWKV_HEAD))
    lnx_g = 1.0 + 0.02 * nrm(ks[22], (L, D_RWKV))
    lnx_b = 0.01 * nrm(ks[23], (L, D_RWKV))
    w_branch = nrm(ks[24], (L, D_SSM + D_RWKV, D_MODEL)) * (D_SSM ** -0.5)
    w_out = nrm(ks[25], (L, D_MODEL, D_MODEL)) * D_MODEL ** -0.5
    norm2_g = 1.0 + 0.02 * nrm(ks[26], (L, D_MODEL))
    w_ff1 = nrm(ks[27], (L, D_MODEL, D_FF)) * D_MODEL ** -0.5
    w_ff2 = nrm(ks[28], (L, D_FF, D_MODEL)) * D_FF ** -0.5
    norm_f_g = 1.0 + 0.02 * nrm(ks[29], (D_MODEL,))
    return {"x": x, "norm1_g": norm1_g, "w_in": w_in,
            "lam_re": lam_re, "lam_im": lam_im, "log_dt": log_dt,
            "b_re": b_re, "b_im": b_im, "c_re": c_re, "c_im": c_im,
            "d_skip": d_skip, "w_glu": w_glu, "b_glu": b_glu,
            "mu_rwkv": mu_rwkv, "w0": w0, "w2": w2, "a0": a0, "a2": a2, "g2": g2,
            "k_k": k_k, "k_a": k_a, "r_k": r_k, "lnx_g": lnx_g, "lnx_b": lnx_b,
            "w_branch": w_branch, "w_out": w_out, "norm2_g": norm2_g,
            "w_ff1": w_ff1, "w_ff2": w_ff2, "norm_f_g": norm_f_g}


def reference(x, norm1_g, w_in, lam_re, lam_im, log_dt, b_re, b_im, c_re, c_im,
              d_skip, w_glu, b_glu, mu_rwkv, w0, w2, a0, a2, g2, k_k, k_a, r_k,
              lnx_g, lnx_b, w_branch, w_out, norm2_g, w_ff1, w_ff2, norm_f_g):
    s1 = D_SSM
    s2 = D_SSM + D_RWKV_IN
    s3 = s2 + D_MODEL
    for l in range(DEPTH):
        h = rmsnorm(x, norm1_g[l])
        proj = h @ w_in[l]
        u = proj[..., :s1]
        p_rwkv = proj[..., s1:s2]
        gate_a = jax.nn.sigmoid(proj[..., s2:s3])
        gate_b = jax.nn.sigmoid(proj[..., s3:])
        o_a = s5_branch(u, lam_re[l], lam_im[l], log_dt[l], b_re[l], b_im[l],
                        c_re[l], c_im[l], d_skip[l], w_glu[l], b_glu[l])
        o_b = rwkv7_branch(p_rwkv, mu_rwkv[l], w0[l], w2[l], a0[l], a2[l], g2[l],
                           k_k[l], k_a[l], r_k[l], lnx_g[l], lnx_b[l])
        wb = w_branch[l]
        merged = gate_a * (o_a @ wb[:D_SSM]) + gate_b * (o_b @ wb[D_SSM:])
        x = x + merged @ w_out[l]
        h2 = rmsnorm(x, norm2_g[l])
        x = x + jnp.square(jax.nn.relu(h2 @ w_ff1[l])) @ w_ff2[l]
    return rmsnorm(x, norm_f_g)
```

```cpp
#include <hip/hip_runtime.h>
#include <hip/hip_cooperative_groups.h>
#include <cstdio>
#include <cstdint>
namespace cg = cooperative_groups;
namespace pg8 {
#define PG8_LAS __attribute__((address_space(3)))
typedef unsigned short bf16_t;
typedef short bf16x8 __attribute__((ext_vector_type(8)));
typedef float f32x4 __attribute__((ext_vector_type(4)));
typedef unsigned u32x4 __attribute__((ext_vector_type(4)));
constexpr int BM = 256, BK = 64, HALF = 128, HTB = HALF * BK * 2  , STAGE_BYTES = 8 * HTB, NXCD = 8, WGM = 8;

__host__ __device__ __forceinline__ int lds_byte(int r, int c) { const int st = (r >> 4) * 2 + (c >> 5), rr = r & 15, cc = c & 31, ob = rr * 64 + cc * 2; return st * 1024 + (ob ^ (((ob >> 9) & 1) << 5)); }
__host__ __device__ __forceinline__ void stage_rc(int b, int& R, int& C) { const int st = b / 1024, sb = b % 1024, swz = sb ^ (((sb >> 9) & 1) << 5); R = (st >> 1) * 16 + swz / 64; C = (st & 1) * 32 + (swz % 64) / 2; }
__host__ __device__ __forceinline__ int perm32(int rho) { const int n = rho >> 4, i = rho & 15; return 8 * (i >> 2) + 4 * n + (i & 3); }

struct Unit { int pm, pn; };
struct Gemm { const bf16_t* A; const bf16_t* Bt; int M, N, K; };

struct StaticOrder {
    int nM, nN, nwg, G, c;
    __host__ __device__ void init(int M, int N, int G_, int c_) { nM = M / BM; nN = N / BM; nwg = nM * nN; G = G_; c = c_; }
    __host__ __device__ bool next(int i, Unit& u) const {
        const long L = (long)i * G + c; if (L >= nwg) return false;
        int wgid = (int)L; { const int q = nwg / NXCD, r = nwg % NXCD, xcd = wgid % NXCD, off = wgid / NXCD; wgid = (xcd < r ? xcd * (q + 1) : r * (q + 1) + (xcd - r) * q) + off; }
        const int nig = WGM * nN, gid = wgid / nig, fm = gid * WGM, gsz = (nM - fm) < WGM ? (nM - fm) : WGM;
        u.pm = fm + ((wgid % nig) % gsz); u.pn = (wgid % nig) / gsz; return true;
    }
    __device__ __forceinline__ void a_ready(const Unit&) const {}
    __device__ __forceinline__ void done(const Unit&) const {}
};

__device__ __forceinline__ unsigned cvt_pk_bf16(float lo, float hi) { unsigned r; asm volatile("v_cvt_pk_bf16_f32 %0, %1, %2" : "=v"(r) : "v"(lo), "v"(hi)); return r; }
template <class Epi, class Sched, bool ALIGN_EPI = false, bool SP2 = false>
__device__ __forceinline__ void gemm_phase(PG8_LAS unsigned char* lds, const Gemm g, const Sched& S, const Epi& E) {
    int tid_ = threadIdx.x; asm volatile("" : "+v"(tid_));
    const int tid = tid_, wid = __builtin_amdgcn_readfirstlane(tid >> 6), lane = tid & 63, wr = wid >> 2, wc = wid & 3, fr = lane & 15, fq = lane >> 4;
    const int K = g.K, nt = K / BK;
    unsigned voffA[2], voffB[2];
#pragma unroll
    for (int i = 0; i < 2; ++i) { int R, C; stage_rc(tid * 16 + i * 8192, R, C); const int Rb = Epi::PERM ? ((R & ~31) + perm32(R & 31)) : R;
        voffA[i] = (unsigned)(R * K + C) * 2u; voffB[i] = (unsigned)(Rb * K + C) * 2u; }
    const size_t kstep = (size_t)(BK * 2);
    const size_t hstep = (size_t)HALF * K * 2;
    const size_t tstep = 2 * hstep;
    const unsigned ldsw = (unsigned)wid * 1024u;
    const int aoff = lds_byte(wr * 64 + fr, fq * 8), boff = lds_byte(wc * 32 + fr, fq * 8);
#define PG8_SA(b, h) (((b) * 2 + (h)) * HTB)
#define PG8_SB(b, h) ((4 + (b) * 2 + (h)) * HTB)
#define PG8_STAGE(bufoff, gbase, voff) do { _Pragma("unroll") for (int _i = 0; _i < 2; ++_i) \
        __builtin_amdgcn_global_load_lds((const unsigned*)((const char*)(gbase) + (voff)[_i]), (PG8_LAS unsigned*)(lds + (bufoff) + ldsw + _i * 8192), 16, 0, 0); } while (0)
#define PG8_LDA(dst, b, h) do { _Pragma("unroll") for (int m = 0; m < 4; ++m) _Pragma("unroll") for (int k = 0; k < 2; ++k) dst[m][k] = *(const PG8_LAS bf16x8*)(lds + PG8_SA(b, h) + aoff + m * 2048 + k * 1024); } while (0)
#define PG8_LDB(dst, b, h) do { _Pragma("unroll") for (int n = 0; n < 2; ++n) _Pragma("unroll") for (int k = 0; k < 2; ++k) dst[n][k] = *(const PG8_LAS bf16x8*)(lds + PG8_SB(b, h) + boff + n * 2048 + k * 1024); } while (0)
#define PG8_MMA(ai, bj, At, Bt) do { __builtin_amdgcn_s_setprio(1); _Pragma("unroll") for (int m = 0; m < 4; ++m) _Pragma("unroll") for (int n = 0; n < 2; ++n) _Pragma("unroll") for (int k = 0; k < 2; ++k) \
        acc[ai][bj][m][n] = __builtin_amdgcn_mfma_f32_16x16x32_bf16(Bt[n][k], At[m][k], acc[ai][bj][m][n], 0, 0, 0); __builtin_amdgcn_s_setprio(0); } while (0)
#define PG8_WAIT_V(n) asm volatile("s_waitcnt vmcnt(" #n ")" ::: "memory")
#define PG8_WAIT_L(n) asm volatile("s_waitcnt lgkmcnt(" #n ")" ::: "memory")
#define PG8_BAR __builtin_amdgcn_s_barrier()
#define PG8_SCHED __builtin_amdgcn_sched_barrier(0)
    Unit cur, nxt; int ui = 0;
    if (!S.next(0, cur)) return;
    f32x4 acc[2][2][4][2];
#pragma unroll
    for (int a = 0; a < 2; ++a)
#pragma unroll
        for (int b = 0; b < 2; ++b)
#pragma unroll
            for (int m = 0; m < 4; ++m)
#pragma unroll
                for (int n = 0; n < 2; ++n) acc[a][b][m][n] = (f32x4){0.f, 0.f, 0.f, 0.f};
    bf16x8 At[4][2], B0[2][2], B1[2][2];
    const char* cA = (const char*)g.A + (size_t)cur.pm * tstep; const char* cB = (const char*)g.Bt + (size_t)cur.pn * tstep;
    S.a_ready(cur);
    if constexpr (SP2) {
        PG8_STAGE(PG8_SB(0, 0), cB, voffB); PG8_STAGE(PG8_SB(0, 1), cB + hstep, voffB); PG8_STAGE(PG8_SA(0, 0), cA, voffA); PG8_STAGE(PG8_SA(0, 1), cA + hstep, voffA);
        if (wr == 1) PG8_BAR;
        PG8_WAIT_V(2); PG8_BAR;
        PG8_STAGE(PG8_SB(1, 0), cB + kstep, voffB); PG8_STAGE(PG8_SA(1, 0), cA + kstep, voffA); PG8_STAGE(PG8_SB(1, 1), cB + hstep + kstep, voffB);
        PG8_WAIT_V(6); PG8_BAR;
    } else {
        PG8_STAGE(PG8_SB(0, 0), cB, voffB); PG8_STAGE(PG8_SA(0, 0), cA, voffA); PG8_STAGE(PG8_SB(0, 1), cB + hstep, voffB); PG8_STAGE(PG8_SA(0, 1), cA + hstep, voffA);
        if (wr == 1) PG8_BAR;
        PG8_WAIT_V(4); PG8_BAR;
        PG8_STAGE(PG8_SB(1, 0), cB + kstep, voffB); PG8_STAGE(PG8_SA(1, 0), cA + kstep, voffA); PG8_STAGE(PG8_SB(1, 1), cB + hstep + kstep, voffB);
        PG8_WAIT_V(6); PG8_BAR;
    }
    for (;;) {
        const bool has_next = S.next(ui + 1, nxt);
        const char* nA = has_next ? (const char*)g.A + (size_t)nxt.pm * tstep : cA; const char* nB = has_next ? (const char*)g.Bt + (size_t)nxt.pn * tstep : cB;
        for (int t = 0; t < nt; t += 2) {
            const bool last = (t == nt - 2);
            const char* a1 = cA + (size_t)(t + 1) * kstep;
            const char* a2 = last ? nA : cA + (size_t)(t + 2) * kstep; const char* b2 = last ? nB : cB + (size_t)(t + 2) * kstep;
            const char* a3 = a2 + kstep; const char* b3 = b2 + kstep;
            if (last && has_next) S.a_ready(nxt);
            if constexpr (SP2) {
            PG8_LDB(B0, 0, 0); PG8_LDB(B1, 0, 1); PG8_SCHED; PG8_LDA(At, 0, 0); PG8_STAGE(PG8_SA(1, 1), a1 + hstep, voffA);
            PG8_WAIT_V(8); PG8_WAIT_L(0); PG8_BAR; PG8_MMA(0, 0, At, B0); PG8_MMA(0, 1, At, B1); PG8_BAR; PG8_SCHED;
            PG8_LDA(At, 0, 1); PG8_STAGE(PG8_SB(0, 0), b2, voffB); PG8_STAGE(PG8_SB(0, 1), b2 + hstep, voffB); PG8_STAGE(PG8_SA(0, 0), a2, voffA);
            PG8_WAIT_V(8); PG8_WAIT_L(0); PG8_BAR; PG8_MMA(1, 0, At, B0); PG8_MMA(1, 1, At, B1); PG8_BAR; PG8_SCHED;
            PG8_LDB(B0, 1, 0); PG8_LDB(B1, 1, 1); PG8_SCHED; PG8_LDA(At, 1, 0); PG8_STAGE(PG8_SA(0, 1), a2 + hstep, voffA);
            PG8_WAIT_V(8); PG8_WAIT_L(0); PG8_BAR; PG8_MMA(0, 0, At, B0); PG8_MMA(0, 1, At, B1); PG8_BAR; PG8_SCHED;
            PG8_LDA(At, 1, 1); PG8_STAGE(PG8_SB(1, 0), b3, voffB); PG8_STAGE(PG8_SB(1, 1), b3 + hstep, voffB); PG8_STAGE(PG8_SA(1, 0), a3, voffA);
            PG8_WAIT_V(8); PG8_WAIT_L(0); PG8_BAR; PG8_MMA(1, 0, At, B0); PG8_MMA(1, 1, At, B1); PG8_BAR; PG8_SCHED;
            } else {
            PG8_LDB(B0, 0, 0); PG8_SCHED; PG8_LDA(At, 0, 0); PG8_STAGE(PG8_SA(1, 1), a1 + hstep, voffA);
            PG8_WAIT_L(8); PG8_BAR; PG8_WAIT_L(0); PG8_MMA(0, 0, At, B0); PG8_BAR; PG8_SCHED;
            PG8_LDB(B1, 0, 1); PG8_STAGE(PG8_SB(0, 0), b2, voffB);
            PG8_BAR; PG8_WAIT_L(0); PG8_MMA(0, 1, At, B1); PG8_BAR;
            PG8_LDA(At, 0, 1); PG8_STAGE(PG8_SA(0, 0), a2, voffA);
            PG8_BAR; PG8_WAIT_L(0); PG8_MMA(1, 0, At, B0); PG8_BAR; PG8_SCHED;
            PG8_STAGE(PG8_SB(0, 1), b2 + hstep, voffB);
            PG8_WAIT_V(6); PG8_BAR; PG8_MMA(1, 1, At, B1); PG8_BAR;
            PG8_LDB(B0, 1, 0); PG8_SCHED; PG8_LDA(At, 1, 0); PG8_STAGE(PG8_SA(0, 1), a2 + hstep, voffA);
            PG8_WAIT_L(8); PG8_BAR; PG8_WAIT_L(0); PG8_MMA(0, 0, At, B0); PG8_BAR; PG8_SCHED;
            PG8_LDB(B1, 1, 1); PG8_STAGE(PG8_SB(1, 0), b3, voffB);
            PG8_BAR; PG8_WAIT_L(0); PG8_MMA(0, 1, At, B1); PG8_BAR;
            PG8_LDA(At, 1, 1); PG8_STAGE(PG8_SA(1, 0), a3, voffA);
            PG8_BAR; PG8_WAIT_L(0); PG8_MMA(1, 0, At, B0); PG8_BAR; PG8_SCHED;
            PG8_STAGE(PG8_SB(1, 1), b3 + hstep, voffB);
            PG8_WAIT_V(6); PG8_BAR; PG8_MMA(1, 1, At, B1); PG8_BAR;
            }
        }
        if constexpr (ALIGN_EPI) { if (wr == 0) PG8_BAR; }
        if constexpr (!Epi::AFTER_DRAIN) { E(acc, cur, wr, wc, fr, fq); S.done(cur); }
        if (!has_next) break;
#pragma unroll
        for (int a = 0; a < 2; ++a)
#pragma unroll
            for (int b = 0; b < 2; ++b)
#pragma unroll
                for (int m = 0; m < 4; ++m)
#pragma unroll
                    for (int n = 0; n < 2; ++n) acc[a][b][m][n] = (f32x4){0.f, 0.f, 0.f, 0.f};
        cur = nxt; cA = nA; cB = nB; ++ui;
        if constexpr (ALIGN_EPI) { if (wr == 1) PG8_BAR; }
    }
    PG8_WAIT_V(0);
    if constexpr (!ALIGN_EPI) { if (wr == 0) PG8_BAR; }
    PG8_BAR;
    if constexpr (Epi::AFTER_DRAIN) { E.fused(acc, cur, wr, wc, fr, fq, lds, wid, lane); S.done(cur); }
#undef PG8_SA
#undef PG8_SB
#undef PG8_STAGE
#undef PG8_LDA
#undef PG8_LDB
#undef PG8_MMA
#undef PG8_WAIT_V
#undef PG8_WAIT_L
#undef PG8_BAR
#undef PG8_SCHED
}
}

#ifndef MK_LAUNCHES
#define MK_LAUNCHES 1
#endif
#define LAS __attribute__((address_space(3)))
typedef unsigned short bf16;
typedef float f4 __attribute__((ext_vector_type(4)));
typedef float f2 __attribute__((ext_vector_type(2)));
typedef unsigned u4 __attribute__((ext_vector_type(4)));
typedef unsigned u2 __attribute__((ext_vector_type(2)));

constexpr int T = 16384, SEQ = 8192, DM = 1024, DS = 512, DR = 512, NP = 1792, DFF = 4096;
constexpr int NTHREADS = 512, NWAVES = 8, LDS_BYTES = 131072 + 64, NPHASES = 11;
constexpr int S5_TC = 64, S5_NCH = SEQ / S5_TC;
constexpr int RW_CH = 32;
constexpr int NREC = 64;
constexpr size_t MiB = 1u << 20;
constexpr size_t WS_ROWSQ1 = 0, WS_ROWSQ2 = 65536, WS_ABAR = 131072, WS_ATC = 147456, WS_BBAR = 163840, WS_CT = 425984;
constexpr size_t WS_BAR = 917504, WS_BAR_BYTES = 32768;
constexpr size_t WS_WIN = 1 * MiB, WS_WGLU = WS_WIN + (size_t)4352 * 1024 * 2, WS_WBA = 10 * MiB, WS_WBB = 11 * MiB, WS_WOUT = 12 * MiB, WS_W1 = 14 * MiB, WS_W2 = 22 * MiB;
constexpr size_t WS_H = 30 * MiB;
constexpr size_t WS_R = 62 * MiB, WS_K = 78 * MiB, WS_V = 94 * MiB, WS_KK = 110 * MiB, WS_P = 126 * MiB, WS_W = 182 * MiB, WS_B = 214 * MiB, WS_G = 230 * MiB, WS_RK = 246 * MiB, WS_E = 247 * MiB;
constexpr size_t WS_PBT = 126 * MiB, WS_PKT = 142 * MiB, WS_MKTT = 158 * MiB, WS_GC = 251 * MiB;
constexpr size_t WS_W2T = 251 * MiB + 512 * 1024, WS_A2T = WS_W2T + 65536, WS_G2T = WS_A2T + 65536;
constexpr size_t WS_CTB = WS_G2T + 131072;
constexpr size_t WS_BBT = WS_CTB + 131072;
constexpr size_t WS_Y = 182 * MiB, WS_OB = 158 * MiB, WS_T1 = 62 * MiB, WS_T2 = 182 * MiB, WS_MERGED = 214 * MiB, WS_X1 = 62 * MiB, WS_XG = 30 * MiB, WS_F = 126 * MiB, WS_END = 254 * MiB;
static_assert(WS_WGLU + 512 * 512 * 2 <= WS_WBA && WS_CT + 32 * 64 * 32 * 4 <= WS_WIN, "ws map");
constexpr size_t DO_U = 0, DO_Z = 32 * MiB, DO_OA = 48 * MiB;

struct Args { const float* in[30]; float* out; unsigned char* ws; int ph_lo, ph_hi; };

struct Ctx {
    const float* const* in; float* out; unsigned char* ws;
};

__device__ __forceinline__ unsigned f2bf(float f) { unsigned u = __builtin_bit_cast(unsigned, f); return (u + 0x7fffu + ((u >> 16) & 1u)) >> 16; }
typedef __bf16 bf16x2e __attribute__((ext_vector_type(2)));
__device__ __forceinline__ unsigned pk2(float lo, float hi) { f2 v = {lo, hi}; bf16x2e b = __builtin_convertvector(v, bf16x2e); return __builtin_bit_cast(unsigned, b); }
__device__ __forceinline__ float bf2f(bf16 b) { return __builtin_bit_cast(float, (unsigned)b << 16); }
__device__ __forceinline__ float bflo(unsigned u) { return __builtin_bit_cast(float, u << 16); }
__device__ __forceinline__ float bfhi(unsigned u) { return __builtin_bit_cast(float, u & 0xffff0000u); }
__device__ __forceinline__ float sigm(float x) { return __builtin_amdgcn_rcpf(1.0f + __expf(-x)); }
__device__ __forceinline__ float tanh_f(float x) { return 1.0f - 2.0f * __builtin_amdgcn_rcpf(1.0f + __expf(2.0f * x)); }
__device__ __forceinline__ float wave_sum(float v) {
#pragma unroll
    for (int o = 1; o < 64; o <<= 1) v += __shfl_xor(v, o);
    return v;
}
#define LDS_FENCE() asm volatile("s_waitcnt lgkmcnt(0)" ::: "memory")
__device__ __forceinline__ int opaque_tid() { int t = threadIdx.x; asm volatile("" : "+v"(t)); return t; }


constexpr int BW_CENSUS = 0, BW_GLOBAL = 256, BW_XCD = 2048;
__device__ __forceinline__ unsigned xcc_id() { return (unsigned)__builtin_amdgcn_s_getreg((3 << 11) | 20) & 0xFu; }
__device__ __forceinline__ void grid_barrier_census(unsigned* bar, unsigned nblocks, volatile LAS unsigned* st) {
    __syncthreads();
    if (threadIdx.x == 0) {
        const unsigned x = xcc_id();
        __hip_atomic_fetch_add(bar + BW_CENSUS + x, 1u, __ATOMIC_RELAXED, __HIP_MEMORY_SCOPE_AGENT);
        unsigned* p = bar + BW_GLOBAL;
        __hip_atomic_fetch_add(p, 1u, __ATOMIC_RELEASE, __HIP_MEMORY_SCOPE_AGENT);
        unsigned spins = 0;
        while (__hip_atomic_load(p, __ATOMIC_RELAXED, __HIP_MEMORY_SCOPE_AGENT) < nblocks && ++spins < (1u << 22)) __builtin_amdgcn_s_sleep(1);
        __builtin_amdgcn_fence(__ATOMIC_ACQUIRE, "agent");
        unsigned nx = 0, nxcd = 0;
        for (unsigned i = 0; i < 16; ++i) { const unsigned v = __hip_atomic_load(bar + BW_CENSUS + i, __ATOMIC_RELAXED, __HIP_MEMORY_SCOPE_AGENT); nxcd += (v != 0u); if (i == x) nx = v; }
        st[0] = nx; st[1] = nxcd;
    }
    __syncthreads();
}
__device__ __forceinline__ void grid_barrier_xcd(unsigned* bar, int k, volatile LAS unsigned* st) {
    __syncthreads();
    if (threadIdx.x == 0) {
        const unsigned x = xcc_id(), nx = st[0], nxcd = st[1];
        unsigned* g = bar + BW_GLOBAL + 64 * k;
        const unsigned old = __hip_atomic_fetch_add(bar + BW_XCD + (k * 16 + (int)x) * 16, 1u, __ATOMIC_RELAXED, __HIP_MEMORY_SCOPE_AGENT);
        if (old + 1u == nx) { __builtin_amdgcn_fence(__ATOMIC_RELEASE, "agent"); __hip_atomic_fetch_add(g, 1u, __ATOMIC_RELAXED, __HIP_MEMORY_SCOPE_AGENT); }
        unsigned spins = 0;
        while (__hip_atomic_load(g, __ATOMIC_RELAXED, __HIP_MEMORY_SCOPE_AGENT) < nxcd && ++spins < (1u << 22)) __builtin_amdgcn_s_sleep(1);
        __builtin_amdgcn_fence(__ATOMIC_ACQUIRE, "agent");
    }
    __syncthreads();
}

__device__ __forceinline__ void p0_transpose_item(const float* W, int K, int N, bf16* WT, LAS float* scr, int item, int lane, int nb0 = 0, int nbn = 0) {
    const int nblk = nbn ? nbn : N / 32, kb = item / nblk, nb = nb0 + item % nblk, k0 = 64 * kb, n0 = 32 * nb;
    f4 wv_[8];
#pragma unroll
    for (int i = 0; i < 8; ++i) wv_[i] = *(const f4*)(W + (size_t)(k0 + 8 * i + (lane >> 3)) * N + n0 + (lane & 7) * 4);
#pragma unroll
    for (int i = 0; i < 8; ++i) { LAS float* d = scr + (8 * i + (lane >> 3)) * 33 + (lane & 7) * 4; d[0] = wv_[i].x; d[1] = wv_[i].y; d[2] = wv_[i].z; d[3] = wv_[i].w; }
    LDS_FENCE();
    const int c = lane & 7;
#pragma unroll
    for (int j = 0; j < 4; ++j) { const int n = (lane >> 3) + 8 * j; const LAS float* s = scr + (8 * c) * 33 + n;
        u4 o; o.x = pk2(s[0 * 33], s[1 * 33]); o.y = pk2(s[2 * 33], s[3 * 33]); o.z = pk2(s[4 * 33], s[5 * 33]); o.w = pk2(s[6 * 33], s[7 * 33]);
        *(u4*)(WT + (size_t)(n0 + n) * K + k0 + 8 * c) = o; }
    LDS_FENCE();
}

__device__ __forceinline__ void p0_weights_late(const Ctx& c, LAS unsigned char* lds, int vb, int nvb) {
    const int tid = opaque_tid(), lane = tid & 63, wave = tid >> 6;
    LAS float* scr = (LAS float*)(lds + wave * 16384);
    const int gw = vb * NWAVES + wave, NGW = nvb * NWAVES;
    unsigned char* ws = c.ws;
    constexpr int I_INB = 16 * 64, I_GLU = 8 * 16, I_BA = 8 * 32, I_OUT = 16 * 32, I_1 = 16 * 128, I_2 = 64 * 32;
    constexpr int NITEMS = I_INB + I_GLU + 2 * I_BA + I_OUT + I_1 + I_2;
    for (int it = gw; it < NITEMS; it += NGW) {
        int r = it;
        if (r < I_INB) { p0_transpose_item(c.in[2], 1024, 4352, (bf16*)(ws + WS_WIN), scr, r, lane, 72, 64); continue; } r -= I_INB;
        if (r < I_GLU) { p0_transpose_item(c.in[11], 512, 512, (bf16*)(ws + WS_WGLU), scr, r, lane); continue; } r -= I_GLU;
        if (r < I_BA) { p0_transpose_item(c.in[24], 512, 1024, (bf16*)(ws + WS_WBA), scr, r, lane); continue; } r -= I_BA;
        if (r < I_BA) { p0_transpose_item(c.in[24] + 512 * 1024, 512, 1024, (bf16*)(ws + WS_WBB), scr, r, lane); continue; } r -= I_BA;
        if (r < I_OUT) { p0_transpose_item(c.in[25], 1024, 1024, (bf16*)(ws + WS_WOUT), scr, r, lane); continue; } r -= I_OUT;
        if (r < I_1) { p0_transpose_item(c.in[27], 1024, 4096, (bf16*)(ws + WS_W1), scr, r, lane); continue; } r -= I_1;
        p0_transpose_item(c.in[28], 4096, 1024, (bf16*)(ws + WS_W2), scr, r, lane);
    }
    __syncthreads();
}

__device__ __forceinline__ void p0_prologue(const Ctx& c, LAS unsigned char* lds, int vb, int nvb) {
    const int tid = opaque_tid(), lane = tid & 63, wave = tid >> 6;
    LAS float* scr = (LAS float*)(lds + wave * 16384);
    const int gw = vb * NWAVES + wave, NGW = nvb * NWAVES;
    unsigned char* ws = c.ws;
    constexpr int I_INA = 16 * 72, I_L64 = 16, I_L128 = 32;
    constexpr int NITEMS = I_INA + 2 * I_L64 + I_L128;
    for (int it = gw; it < NITEMS; it += NGW) {
        int r = it;
        if (r < I_INA) { p0_transpose_item(c.in[2], 1024, 4352, (bf16*)(ws + WS_WIN), scr, r, lane, 0, 72); continue; } r -= I_INA;
        if (r < I_L64) { p0_transpose_item(c.in[15], 64, 512, (bf16*)(ws + WS_W2T), scr, r, lane); continue; } r -= I_L64;
        if (r < I_L64) { p0_transpose_item(c.in[17], 64, 512, (bf16*)(ws + WS_A2T), scr, r, lane); continue; } r -= I_L64;
        p0_transpose_item(c.in[18], 128, 512, (bf16*)(ws + WS_G2T), scr, r, lane);
    }
    {
        const float* x = c.in[0]; const float* g1 = c.in[1]; bf16* H = (bf16*)(ws + WS_H);
        f4 gv[4];
#pragma unroll
        for (int j = 0; j < 4; ++j) gv[j] = ((const f4*)g1)[lane + 64 * j];
#pragma unroll 4
        for (int m = gw; m < T; m += NGW) {
            const f4* xr = (const f4*)(x + (size_t)m * DM) + lane;
            f4 v[4]; float s = 0.f;
#pragma unroll
            for (int j = 0; j < 4; ++j) { v[j] = xr[64 * j]; s += (v[j].x * v[j].x + v[j].y * v[j].y) + (v[j].z * v[j].z + v[j].w * v[j].w); }
            const float rs = __builtin_amdgcn_rsqf(wave_sum(s) * (1.0f / DM) + 1e-6f);
            u2* o = (u2*)(H + (size_t)m * DM) + lane;
#pragma unroll
            for (int j = 0; j < 4; ++j) { f4 w = v[j] * rs * gv[j]; u2 q; q.x = pk2(w.x, w.y); q.y = pk2(w.z, w.w); o[64 * j] = q; }
        }
    }
    const int gt = vb * NTHREADS + tid, NGT = nvb * NTHREADS;
    for (int i = gt; i < 2 * T; i += NGT) ((float*)(ws + WS_ROWSQ1))[i] = 0.f;
    for (int i = gt; i < 32 * 64; i += NGT) {
        const int g = i >> 6, p = i & 63;
        const float lr = fminf(c.in[3][i], -1e-4f), li = c.in[4][i], dt = expf(c.in[5][g]);
        const float mag = expf(lr * dt); float sn, cs; sincosf(li * dt, &sn, &cs);
        const float are = mag * cs, aim = mag * sn;
        const float den = lr * lr + li * li, xm1 = are - 1.0f;
        const float qre = (xm1 * lr + aim * li) / den, qim = (aim * lr - xm1 * li) / den;
        ((f2*)(ws + WS_ABAR))[i] = (f2){are, aim};
        const float magT = expf(lr * dt * (float)S5_TC); float snT, csT; sincosf(li * dt * (float)S5_TC, &snT, &csT);
        ((f2*)(ws + WS_ATC))[i] = (f2){magT * csT, magT * snT};
        float* bb = (float*)(ws + WS_BBAR) + (size_t)i * 32; float* ct = (float*)(ws + WS_CT) + (size_t)i * 32;
        for (int m = 0; m < 16; ++m) {
            const float br = c.in[6][(size_t)i * 16 + m], bi = c.in[7][(size_t)i * 16 + m];
            bb[m] = qre * br - qim * bi; bb[16 + m] = qre * bi + qim * br;
            ((bf16*)(ws + WS_BBT))[(size_t)(g * 128 + p) * 16 + m] = (bf16)f2bf(qre * br - qim * bi); ((bf16*)(ws + WS_BBT))[(size_t)(g * 128 + 64 + p) * 16 + m] = (bf16)f2bf(qre * bi + qim * br);
            ct[m] = c.in[8][(size_t)(g * 16 + m) * 64 + p]; ct[16 + m] = c.in[9][(size_t)(g * 16 + m) * 64 + p];
            ((bf16*)(ws + WS_CTB))[(size_t)(g * 16 + m) * 128 + p] = (bf16)f2bf(c.in[8][(size_t)(g * 16 + m) * 64 + p]); ((bf16*)(ws + WS_CTB))[(size_t)(g * 16 + m) * 128 + 64 + p] = (bf16)f2bf(-c.in[9][(size_t)(g * 16 + m) * 64 + p]);
        }
    }
}

#define EPI_LOOP_BEGIN \
    const int row0 = u.pm * 256 + wr * 64 + fr, colb = u.pn * 256 + wc * 32 + 8 * fq; \
    _Pragma("unroll") for (int ai = 0; ai < 2; ++ai) _Pragma("unroll") for (int m = 0; m < 4; ++m) { const int row = row0 + ai * 128 + m * 16; (void)row;
#define EPI_BJ_BEGIN _Pragma("unroll") for (int bj = 0; bj < 2; ++bj) { const int col = colb + bj * 128; f4 v0 = acc[ai][bj][m][0], v1 = acc[ai][bj][m][1]; (void)col;
#define EPI_END }
typedef pg8::f32x4 AccT[2][2][4][2];

typedef __bf16 bf16x2q __attribute__((ext_vector_type(2)));
__device__ __forceinline__ unsigned cvtpk_q(float lo, float hi) { f2 v = {lo, hi}; bf16x2q b = __builtin_convertvector(v, bf16x2q); return __builtin_bit_cast(unsigned, b); }
__device__ __forceinline__ u4 pack8(f4 a, f4 b) { u4 w; w.x = cvtpk_q(a.x, a.y); w.y = cvtpk_q(a.z, a.w); w.z = cvtpk_q(b.x, b.y); w.w = cvtpk_q(b.z, b.w); return w; }
__device__ __forceinline__ void unpack8(u4 w, f4& a, f4& b) { a = (f4){bflo(w.x), bfhi(w.x), bflo(w.y), bfhi(w.y)}; b = (f4){bflo(w.z), bfhi(w.z), bflo(w.w), bfhi(w.w)}; }
__device__ __forceinline__ f4 sigm4(f4 v) { return (f4){sigm(v.x), sigm(v.y), sigm(v.z), sigm(v.w)}; }

struct EpiProj {
    static constexpr bool PERM = true, AFTER_DRAIN = false; bf16* U; bf16* P;
    __device__ __forceinline__ void operator()(const AccT& acc, const pg8::Unit& u, int wr, int wc, int fr, int fq) const {
        EPI_LOOP_BEGIN EPI_BJ_BEGIN
            if (u.pn < 2) { *(u4*)(U + (size_t)row * DS + col) = pack8(v0, v1); }
            else { *(u4*)(P + (size_t)row * NP + (col - 512)) = pack8(v0, v1); }
        } EPI_END
    }
};
struct EpiGlu {
    static constexpr bool PERM = true, AFTER_DRAIN = false; const bf16* Z; const float* bias; bf16* OA;
    __device__ __forceinline__ void operator()(const AccT& acc, const pg8::Unit& u, int wr, int wc, int fr, int fq) const {
        EPI_LOOP_BEGIN EPI_BJ_BEGIN
            f4 z0, z1; unpack8(*(const u4*)(Z + (size_t)row * DS + col), z0, z1);
            const f4 b0 = *(const f4*)(bias + col), b1 = *(const f4*)(bias + col + 4);
            *(u4*)(OA + (size_t)row * DS + col) = pack8(z0 * sigm4(v0 + b0), z1 * sigm4(v1 + b1));
        } EPI_END
    }
};
struct EpiGateA {
    static constexpr bool PERM = true, AFTER_DRAIN = false; bf16* T1;
    __device__ __forceinline__ void operator()(const AccT& acc, const pg8::Unit& u, int wr, int wc, int fr, int fq) const {
        EPI_LOOP_BEGIN EPI_BJ_BEGIN
            *(u4*)(T1 + (size_t)row * DM + col) = pack8(sigm4(v0), sigm4(v1));
        } EPI_END
    }
};
struct EpiMulA {
    static constexpr bool PERM = true, AFTER_DRAIN = false; bf16* T1;
    __device__ __forceinline__ void operator()(const AccT& acc, const pg8::Unit& u, int wr, int wc, int fr, int fq) const {
        EPI_LOOP_BEGIN EPI_BJ_BEGIN
            bf16* p = T1 + (size_t)row * DM + col; f4 a, b; unpack8(*(const u4*)p, a, b); *(u4*)p = pack8(a * v0, b * v1);
        } EPI_END
    }
};
struct EpiGateB {
    static constexpr bool PERM = true, AFTER_DRAIN = false; bf16* T2;
    __device__ __forceinline__ void operator()(const AccT& acc, const pg8::Unit& u, int wr, int wc, int fr, int fq) const {
        EPI_LOOP_BEGIN EPI_BJ_BEGIN
            *(u4*)(T2 + (size_t)row * DM + col) = pack8(sigm4(v0), sigm4(v1));
        } EPI_END
    }
};
struct EpiMerge {
    static constexpr bool PERM = true, AFTER_DRAIN = false; const bf16* T1; const bf16* T2; bf16* MG;
    __device__ __forceinline__ void operator()(const AccT& acc, const pg8::Unit& u, int wr, int wc, int fr, int fq) const {
        EPI_LOOP_BEGIN EPI_BJ_BEGIN
            f4 a, b; unpack8(*(const u4*)(T1 + (size_t)row * DM + col), a, b);
            f4 g0, g1; unpack8(*(const u4*)(T2 + (size_t)row * DM + col), g0, g1);
            *(u4*)(MG + (size_t)row * DM + col) = pack8(a + g0 * v0, b + g1 * v1);
        } EPI_END
    }
};
struct EpiWout {
    static constexpr bool PERM = true, AFTER_DRAIN = false; const float* x; const float* g2; bf16* X1; bf16* XG; float* rowsq;
    __device__ __forceinline__ void operator()(const AccT& acc, const pg8::Unit& u, int wr, int wc, int fr, int fq) const {
        EPI_LOOP_BEGIN
            float ss = 0.f;
            EPI_BJ_BEGIN
                const float* xp = x + (size_t)row * DM + col; const f4 a = *(const f4*)xp + v0, b = *(const f4*)(xp + 4) + v1;
                *(u4*)(X1 + (size_t)row * DM + col) = pack8(a, b);
                const f4 ga = *(const f4*)(g2 + col), gb = *(const f4*)(g2 + col + 4);
                *(u4*)(XG + (size_t)row * DM + col) = pack8(a * ga, b * gb);
                ss += (a.x * a.x + a.y * a.y) + (a.z * a.z + a.w * a.w) + (b.x * b.x + b.y * b.y) + (b.z * b.z + b.w * b.w);
            }
            ss += __shfl_xor(ss, 16); ss += __shfl_xor(ss, 32);
            if (fq == 0) atomicAdd(rowsq + row, ss);
        }
    }
};
struct EpiFF1 {
    static constexpr bool PERM = true, AFTER_DRAIN = false; const float* rowsq; bf16* F;
    __device__ __forceinline__ void operator()(const AccT& acc, const pg8::Unit& u, int wr, int wc, int fr, int fq) const {
        EPI_LOOP_BEGIN
            const float rs = __builtin_amdgcn_rsqf(rowsq[row] * (1.0f / DM) + 1e-6f);
            EPI_BJ_BEGIN
                f4 a = v0 * rs, b = v1 * rs;
                a = (f4){fmaxf(a.x, 0.f), fmaxf(a.y, 0.f), fmaxf(a.z, 0.f), fmaxf(a.w, 0.f)}; b = (f4){fmaxf(b.x, 0.f), fmaxf(b.y, 0.f), fmaxf(b.z, 0.f), fmaxf(b.w, 0.f)};
                *(u4*)(F + (size_t)row * DFF + col) = pack8(a * a, b * b);
            }
        }
    }
};
struct EpiFF2 {
    static constexpr bool PERM = true, AFTER_DRAIN = false; bf16* X1; float* rowsq;
    __device__ __forceinline__ void operator()(const AccT& acc, const pg8::Unit& u, int wr, int wc, int fr, int fq) const {
        EPI_LOOP_BEGIN
            float ss = 0.f;
            EPI_BJ_BEGIN
                bf16* xp = X1 + (size_t)row * DM + col; f4 a, b; unpack8(*(const u4*)xp, a, b); a += v0; b += v1;
                *(u4*)xp = pack8(a, b);
                ss += (a.x * a.x + a.y * a.y) + (a.z * a.z + a.w * a.w) + (b.x * b.x + b.y * b.y) + (b.z * b.z + b.w * b.w);
            }
            ss += __shfl_xor(ss, 16); ss += __shfl_xor(ss, 32);
            if (fq == 0) atomicAdd(rowsq + row, ss);
        }
    }
};

template <class Epi>
__device__ __forceinline__ void run_gemm(LAS unsigned char* lds, const bf16* A, const bf16* Bt, int N, int K, const Epi& E, int vb, int nvb) {
    pg8::Gemm g{A, Bt, T, N, K}; pg8::StaticOrder S; S.init(T, N, nvb, vb);
    pg8::gemm_phase<Epi, pg8::StaticOrder, true, true>(lds, g, S, E);
}

typedef short bf16x8p __attribute__((ext_vector_type(8)));
typedef __bf16 bf16x2p __attribute__((ext_vector_type(2)));
__device__ __forceinline__ unsigned cvtpk_p(float lo, float hi) { f2 v = {lo, hi}; bf16x2p b = __builtin_convertvector(v, bf16x2p); return __builtin_bit_cast(unsigned, b); }
__device__ __forceinline__ u2 pack4p(f4 a) { u2 w; w.x = cvtpk_p(a.x, a.y); w.y = cvtpk_p(a.z, a.w); return w; }
__device__ __forceinline__ f4 unpack4(u2 w) { return (f4){bflo(w.x), bfhi(w.x), bflo(w.y), bfhi(w.y)}; }
__device__ __forceinline__ f4 mfma16p(bf16x8p a, bf16x8p b, f4 c) { return __builtin_amdgcn_mfma_f32_16x16x32_bf16(a, b, c, 0, 0, 0); }
__device__ __forceinline__ void rwkv_prep(const Ctx& c, LAS unsigned char* lds, int vb, int nvb) {
    constexpr int XP = 528;
    const int tid = opaque_tid(), lane = tid & 63, wave = tid >> 6, lr = lane & 15, lq = lane >> 4, h = wave;
    unsigned char* ws = c.ws;
    const bf16* P = (const bf16*)(ws + WS_P);
    const float* mu = c.in[13];
    bf16* Ro = (bf16*)(ws + WS_R); bf16* Ko = (bf16*)(ws + WS_K); bf16* Vo = (bf16*)(ws + WS_V); bf16* KKo = (bf16*)(ws + WS_KK); bf16* Bo = (bf16*)(ws + WS_B);
    float* Wo = (float*)(ws + WS_W); bf16* Go = (bf16*)(ws + WS_G); float* RKo = (float*)(ws + WS_RK);
    const bf16* W2T = (const bf16*)(ws + WS_W2T); const bf16* A2T = (const bf16*)(ws + WS_A2T); const bf16* G2T = (const bf16*)(ws + WS_G2T);
#pragma unroll 1
    for (int tile = vb; tile < T / 32; tile += nvb) {
        const int t0 = tile * 32;
        __syncthreads();
#pragma unroll 4
        for (int i = 0; i < 16; ++i) {
            const int idx = i * 512 + tid, tok = idx >> 8, col = idx & 255, t = t0 + tok, pc = 1536 + col;
            const float p = bf2f(P[(size_t)t * NP + pc]); const float pv = ((t & (SEQ - 1)) == 0) ? 0.f : bf2f(P[(size_t)(t - 1) * NP + pc]);
            const float pm = p + (pv - p) * mu[pc];
            float o; if (col < 128) o = sigm(pm); else if (col < 192) o = tanh_f(pm); else o = pm;
            *(LAS bf16*)(lds + tok * XP + col * 2) = (bf16)f2bf(o);
        }
        __syncthreads();
#pragma unroll 1
        for (int tk = 0; tk < 2; ++tk) {
            f4 aW[4], aA[4], aG[4];
            {
                const LAS unsigned char* xr = lds + (16 * tk + lr) * XP + 16 * lq;
                const bf16x8p bW0 = *(const LAS bf16x8p*)(xr + 256), bW1 = *(const LAS bf16x8p*)(xr + 320), bA0 = *(const LAS bf16x8p*)(xr + 384), bA1 = *(const LAS bf16x8p*)(xr + 448);
                const bf16x8p bG0 = *(const LAS bf16x8p*)(xr), bG1 = *(const LAS bf16x8p*)(xr + 64), bG2 = *(const LAS bf16x8p*)(xr + 128), bG3 = *(const LAS bf16x8p*)(xr + 192);
#pragma unroll
                for (int ct = 0; ct < 4; ++ct) {
                    const int crow = h * 64 + 16 * ct + lr;
                    const bf16x8p fw0 = *(const bf16x8p*)(W2T + crow * 64 + 8 * lq), fw1 = *(const bf16x8p*)(W2T + crow * 64 + 8 * lq + 32);
                    const bf16x8p fa0 = *(const bf16x8p*)(A2T + crow * 64 + 8 * lq), fa1 = *(const bf16x8p*)(A2T + crow * 64 + 8 * lq + 32);
                    const bf16x8p fg0 = *(const bf16x8p*)(G2T + crow * 128 + 8 * lq), fg1 = *(const bf16x8p*)(G2T + crow * 128 + 8 * lq + 32);
                    const bf16x8p fg2 = *(const bf16x8p*)(G2T + crow * 128 + 8 * lq + 64), fg3 = *(const bf16x8p*)(G2T + crow * 128 + 8 * lq + 96);
                    const f4 z = (f4){0.f, 0.f, 0.f, 0.f};
                    aW[ct] = mfma16p(fw1, bW1, mfma16p(fw0, bW0, z));
                    aA[ct] = mfma16p(fa1, bA1, mfma16p(fa0, bA0, z));
                    aG[ct] = mfma16p(fg3, bG3, mfma16p(fg2, bG2, mfma16p(fg1, bG1, mfma16p(fg0, bG0, z))));
                }
            }
            const int t = t0 + 16 * tk + lr; const bool first = (t & (SEQ - 1)) == 0;
            const bf16* pr = P + (size_t)t * NP; const bf16* pp = first ? pr : pr - NP; const float pf = first ? 0.f : 1.f;
            float n2 = 0.f, rk = 0.f; f4 kkv[4], alr[4];
#pragma unroll
            for (int ct = 0; ct < 4; ++ct) {
                const int c0 = h * 64 + 16 * ct + 4 * lq; const size_t o = (size_t)t * DR + c0;
                f4 r = unpack4(*(const u2*)(pr + c0)), k = unpack4(*(const u2*)(pr + 512 + c0)), v = unpack4(*(const u2*)(pr + 1024 + c0));
                const f4 r1 = unpack4(*(const u2*)(pp + c0)) * pf, k1 = unpack4(*(const u2*)(pp + 512 + c0)) * pf, v1 = unpack4(*(const u2*)(pp + 1024 + c0)) * pf;
                r += (r1 - r) * *(const f4*)(mu + c0); k += (k1 - k) * *(const f4*)(mu + 512 + c0); v += (v1 - v) * *(const f4*)(mu + 1024 + c0);
                const f4 al = sigm4(aA[ct] + *(const f4*)(c.in[16] + c0));
                const f4 kv = k * *(const f4*)(c.in[19] + c0);
                n2 += (kv.x * kv.x + kv.y * kv.y) + (kv.z * kv.z + kv.w * kv.w);
                const f4 k2 = k * (1.0f + (al - 1.0f) * *(const f4*)(c.in[20] + c0));
                const f4 rr = r * k2 * *(const f4*)(c.in[21] + c0);
                rk += (rr.x + rr.y) + (rr.z + rr.w);
                *(u2*)(Ro + o) = pack4p(r); *(u2*)(Ko + o) = pack4p(k2); *(u2*)(Vo + o) = pack4p(v);
                const f4 wa = aW[ct] + *(const f4*)(c.in[14] + c0);
                f4 lw;
                { const float z0 = -wa.x, z1 = -wa.y, z2 = -wa.z, z3 = -wa.w;
                  lw.x = -expf(-((z0 > 20.f) ? z0 : log1pf(expf(z0))) - 0.5f); lw.y = -expf(-((z1 > 20.f) ? z1 : log1pf(expf(z1))) - 0.5f);
                  lw.z = -expf(-((z2 > 20.f) ? z2 : log1pf(expf(z2))) - 0.5f); lw.w = -expf(-((z3 > 20.f) ? z3 : log1pf(expf(z3))) - 0.5f); }
                *(f4*)(Wo + o) = lw;
                *(u2*)(Go + o) = pack4p(aG[ct]);
                kkv[ct] = kv; alr[ct] = al;
            }
            n2 += __shfl_xor(n2, 16); n2 += __shfl_xor(n2, 32); rk += __shfl_xor(rk, 16); rk += __shfl_xor(rk, 32);
            const float inv = 1.0f / fmaxf(sqrtf(n2), 1e-12f);
#pragma unroll
            for (int ct = 0; ct < 4; ++ct) {
                const size_t o = (size_t)t * DR + h * 64 + 16 * ct + 4 * lq;
                const f4 kk = kkv[ct] * inv;
                *(u2*)(KKo + o) = pack4p(kk); *(u2*)(Bo + o) = pack4p(kk * alr[ct]);
            }
            if (lq == 0) RKo[t * 8 + h] = rk;
        }
    }
    __syncthreads();
}

constexpr int S5P = 272;
__device__ __forceinline__ void s5_bu_tile(const bf16x8p (&fa)[8], const LAS unsigned char* ub, LAS unsigned char* xs, int sub, int lr, int lq) {
    bf16x8p fb = (bf16x8p){0, 0, 0, 0, 0, 0, 0, 0};
    if (lq < 2) fb = *(const LAS bf16x8p*)(ub + (sub * 16 + lr) * 32 + 16 * lq);
#pragma unroll
    for (int qt = 0; qt < 8; ++qt) {
        const f4 d = mfma16p(fa[qt], fb, (f4){0.f, 0.f, 0.f, 0.f});
        *(LAS u2*)(xs + lr * S5P + (16 * qt + 4 * lq) * 2) = pack4p(d);
    }
}
__device__ __forceinline__ void s5_load_item(const Ctx& c, int g, int tb, int lane, int lr, int lq, bf16x8p (&fa)[8], LAS unsigned char* ub) {
    const bf16* BBT = (const bf16*)(c.ws + WS_BBT);
#pragma unroll
    for (int qt = 0; qt < 8; ++qt) { fa[qt] = (bf16x8p){0, 0, 0, 0, 0, 0, 0, 0}; if (lq < 2) fa[qt] = *(const bf16x8p*)(BBT + (size_t)(g * 128 + 16 * qt + lr) * 16 + 8 * lq); }
    const bf16* U = (const bf16*)((unsigned char*)c.out + DO_U);
    const u4* up = (const u4*)(U + (size_t)(tb + lane) * DS + 16 * g);
    const u4 w0 = up[0], w1 = up[1];
    *(LAS u4*)(ub + lane * 32) = w0; *(LAS u4*)(ub + lane * 32 + 16) = w1;
}
__device__ __forceinline__ void s5_passA(const Ctx& c, LAS unsigned char* lds, int vb, int nvb) {
    const int tid = opaque_tid(), lane = tid & 63, wave = tid >> 6, lr = lane & 15, lq = lane >> 4;
    LAS unsigned char* ub = lds + wave * 6400;
    LAS unsigned char* xs = ub + 2048;
    unsigned char* ws = c.ws;
    const int gw = vb * NWAVES + wave, NGW = nvb * NWAVES;
#pragma unroll 1
    for (int item = gw; item < 2 * 32 * S5_NCH; item += NGW) {
        const int ck = item & (S5_NCH - 1), g = (item >> 7) & 31, b = item >> 12;
        const f2 ab = ((const f2*)(ws + WS_ABAR))[g * 64 + lane];
        bf16x8p fa[8];
        LDS_FENCE();
        s5_load_item(c, g, b * SEQ + ck * S5_TC, lane, lr, lq, fa, ub);
        LDS_FENCE();
        float xr = 0.f, xi = 0.f;
#pragma unroll 1
        for (int sub = 0; sub < 4; ++sub) {
            s5_bu_tile(fa, ub, xs, sub, lr, lq);
            LDS_FENCE();
#pragma unroll
            for (int t = 0; t < 16; ++t) {
                const float br = bf2f(*(const LAS bf16*)(xs + t * S5P + lane * 2)), bi = bf2f(*(const LAS bf16*)(xs + t * S5P + 128 + lane * 2));
                const float nr = ab.x * xr - ab.y * xi + br, ni = ab.x * xi + ab.y * xr + bi; xr = nr; xi = ni;
            }
            LDS_FENCE();
        }
        ((f2*)(ws + WS_E))[(size_t)((b * 32 + g) * S5_NCH + ck) * 64 + lane] = (f2){xr, xi};
    }
}

__device__ __forceinline__ float gelu_tanh(float y) { const float u = 0.7978845608028654f * (y + 0.044715f * y * y * y); return 0.5f * y * (1.0f + tanh_f(u)); }

__device__ __forceinline__ void s5_passC(const Ctx& c, LAS unsigned char* lds, int vb, int nvb) {
    const int tid = opaque_tid(), lane = tid & 63, wave = tid >> 6, lr = lane & 15, lq = lane >> 4;
    LAS unsigned char* ub = lds + wave * 6400;
    LAS unsigned char* xs = ub + 2048;
    unsigned char* ws = c.ws;
    bf16* Z = (bf16*)((unsigned char*)c.out + DO_Z);
    const bf16* CTB = (const bf16*)(ws + WS_CTB);
    const int gw = vb * NWAVES + wave, NGW = nvb * NWAVES;
#pragma unroll 1
    for (int item = gw; item < 2 * 32 * S5_NCH; item += NGW) {
        const int g = item >> 8, bc = item & 255, b = bc >> 7, ck = bc & (S5_NCH - 1), tb = b * SEQ + ck * S5_TC;
        const f2 ab = ((const f2*)(ws + WS_ABAR))[g * 64 + lane], atc = ((const f2*)(ws + WS_ATC))[g * 64 + lane];
        bf16x8p fa[8], fc[4];
#pragma unroll
        for (int ks = 0; ks < 4; ++ks) fc[ks] = *(const bf16x8p*)(CTB + (size_t)(g * 16 + lr) * 128 + 8 * lq + 32 * ks);
        float xr = 0.f, xi = 0.f;
        { const f2* ep = (const f2*)(ws + WS_E) + (size_t)((b * 32 + g) * S5_NCH) * 64 + lane;
          for (int j = 0; j < ck; ++j) { const f2 e = ep[(size_t)j * 64]; const float nr = atc.x * xr - atc.y * xi + e.x, ni = atc.x * xi + atc.y * xr + e.y; xr = nr; xi = ni; } }
        LDS_FENCE();
        s5_load_item(c, g, tb, lane, lr, lq, fa, ub);
        const f4 dv = *(const f4*)(c.in[10] + 16 * g + 4 * lq);
        LDS_FENCE();
#pragma unroll 1
        for (int sub = 0; sub < 4; ++sub) {
            s5_bu_tile(fa, ub, xs, sub, lr, lq);
            LDS_FENCE();
#pragma unroll
            for (int t = 0; t < 16; ++t) {
                LAS bf16* pr = (LAS bf16*)(xs + t * S5P + lane * 2); LAS bf16* pi = (LAS bf16*)(xs + t * S5P + 128 + lane * 2);
                const float br = bf2f(*pr), bi = bf2f(*pi);
                const float nr = ab.x * xr - ab.y * xi + br, ni = ab.x * xi + ab.y * xr + bi; xr = nr; xi = ni;
                *pr = (bf16)f2bf(xr); *pi = (bf16)f2bf(xi);
            }
            LDS_FENCE();
            f4 a = (f4){0.f, 0.f, 0.f, 0.f};
#pragma unroll
            for (int ks = 0; ks < 4; ++ks) a = mfma16p(fc[ks], *(const LAS bf16x8p*)(xs + lr * S5P + 16 * lq + 64 * ks), a);
            const f4 uu = unpack4(*(const LAS u2*)(ub + (sub * 16 + lr) * 32 + 8 * lq));
            const f4 y = a + dv * uu;
            u2 o; o.x = pk2(gelu_tanh(y.x), gelu_tanh(y.y)); o.y = pk2(gelu_tanh(y.z), gelu_tanh(y.w));
            *(u2*)(Z + (size_t)(tb + sub * 16 + lr) * DS + 16 * g + 4 * lq) = o;
            LDS_FENCE();
        }
    }
    __syncthreads();
}

constexpr int TS = 144;
typedef short bf16x8 __attribute__((ext_vector_type(8)));
typedef __bf16 bf16x2_t __attribute__((ext_vector_type(2)));
__device__ __forceinline__ unsigned cvtpk_s(float lo, float hi) { f2 v = {lo, hi}; bf16x2_t b = __builtin_convertvector(v, bf16x2_t); return __builtin_bit_cast(unsigned, b); }
__device__ __forceinline__ u2 pack4(f4 a) { u2 w; w.x = cvtpk_s(a.x, a.y); w.y = cvtpk_s(a.z, a.w); return w; }
__device__ __forceinline__ f4 mfma16(bf16x8 a, bf16x8 b, f4 c) { return __builtin_amdgcn_mfma_f32_16x16x32_bf16(a, b, c, 0, 0, 0); }
__device__ __forceinline__ bf16x8 ldt(const LAS unsigned char* tile, int row, int colb) { return *(const LAS bf16x8*)(tile + row * TS + colb); }

__device__ __forceinline__ void rwkv_pre(const Ctx& c, LAS unsigned char* lds, int vb, int nvb) {
    const int tid = opaque_tid(), lane = tid & 63, wave = tid >> 6, lr = lane & 15, lq = lane >> 4;
    LAS float* LG = (LAS float*)lds;
    LAS unsigned char* tAT = lds + 16384; LAS unsigned char* tBT = tAT + 9216; LAS unsigned char* tKT = tBT + 9216; LAS unsigned char* tRT = tKT + 9216;
    LAS float* NT = (LAS float*)(lds + 53248);
    LAS float* MK = (LAS float*)(lds + 69632);
    unsigned char* ws = c.ws;
    bf16* Ra = (bf16*)(ws + WS_R); bf16* Ka = (bf16*)(ws + WS_K); bf16* KKa = (bf16*)(ws + WS_KK); bf16* Ba = (bf16*)(ws + WS_B); const float* Wa = (const float*)(ws + WS_W);
    bf16* PBT = (bf16*)(ws + WS_PBT); bf16* PKT = (bf16*)(ws + WS_PKT); bf16* MKTT = (bf16*)(ws + WS_MKTT); float* GC = (float*)(ws + WS_GC);
    const int t = tid >> 3, k8 = (tid & 7) * 8;
    f4 pw0, pw1; u4 pkk, pb, pk, pr;
#define PRE_FETCH(task_) do { const int bh_ = (task_) >> 7, ck_ = (task_) & 127; const size_t go_ = (size_t)((bh_ >> 3) * SEQ + ck_ * 64 + t) * DR + (bh_ & 7) * 64 + k8; \
        pw0 = *(const f4*)(Wa + go_); pw1 = *(const f4*)(Wa + go_ + 4); pkk = *(const u4*)(KKa + go_); pb = *(const u4*)(Ba + go_); pk = *(const u4*)(Ka + go_); pr = *(const u4*)(Ra + go_); } while (0)
    if (vb < 2048) PRE_FETCH(vb);
#pragma unroll 1
    for (int task = vb; task < 2048; task += nvb) {
        const int bh = task >> 7, ck = task & 127, b = bh >> 3, hh = bh & 7, t0 = b * SEQ + ck * 64, cb = hh * 64;
        const size_t go = (size_t)(t0 + t) * DR + cb + k8;
        __syncthreads();
        { *(LAS f4*)(LG + t * 64 + k8) = pw0; *(LAS f4*)(LG + t * 64 + k8 + 4) = pw1; }
        __syncthreads();
        if (wave == 0) { float acc = 0.f;
#pragma unroll 16
            for (int i = 0; i < 64; ++i) { acc += LG[i * 64 + lane]; LG[i * 64 + lane] = acc; } }
        __syncthreads();
        {
            f4 kk0, kk1, b0, b1, k0, k1, r0, r1;
            unpack8(pkk, kk0, kk1); unpack8(pb, b0, b1); unpack8(pk, k0, k1); unpack8(pr, r0, r1);
            const f4 lg0 = *(const LAS f4*)(LG + t * 64 + k8), lg1 = *(const LAS f4*)(LG + t * 64 + k8 + 4);
            f4 lm0 = (f4){0.f, 0.f, 0.f, 0.f}, lm1 = lm0;
            if (t > 0) { lm0 = *(const LAS f4*)(LG + (t - 1) * 64 + k8); lm1 = *(const LAS f4*)(LG + (t - 1) * 64 + k8 + 4); }
            const f4 e0 = (f4){__expf(lg0.x), __expf(lg0.y), __expf(lg0.z), __expf(lg0.w)}, e1 = (f4){__expf(lg1.x), __expf(lg1.y), __expf(lg1.z), __expf(lg1.w)};
            const f4 i0 = (f4){__expf(-lg0.x), __expf(-lg0.y), __expf(-lg0.z), __expf(-lg0.w)}, i1 = (f4){__expf(-lg1.x), __expf(-lg1.y), __expf(-lg1.z), __expf(-lg1.w)};
            const f4 m0 = (f4){__expf(lm0.x), __expf(lm0.y), __expf(lm0.z), __expf(lm0.w)}, m1 = (f4){__expf(lm1.x), __expf(lm1.y), __expf(lm1.z), __expf(lm1.w)};
            *(LAS u4*)(tAT + t * TS + k8 * 2) = pack8(-kk0 * m0, -kk1 * m1);
            *(LAS u4*)(tBT + t * TS + k8 * 2) = pack8(b0 * i0, b1 * i1);
            *(LAS u4*)(tKT + t * TS + k8 * 2) = pack8(k0 * i0, k1 * i1);
            const u4 rt = pack8(r0 * e0, r1 * e1);
            *(LAS u4*)(tRT + t * TS + k8 * 2) = rt;
            *(u4*)(Ra + go) = rt;
            if (tid < 64) GC[task * 64 + tid] = __expf(LG[63 * 64 + tid]);
        }
        __syncthreads();
        {
            const int m = wave >> 1, hf = wave & 1;
            const LAS unsigned char* tA = (m & 1) ? tKT : tBT; const LAS unsigned char* tB = (m < 2) ? tAT : tRT;
#pragma unroll
            for (int st2 = 0; st2 < 2; ++st2) {
                const int st = 2 * hf + st2;
                const bf16x8 a0 = ldt(tA, 16 * st + lr, 16 * lq), a1 = ldt(tA, 16 * st + lr, 16 * lq + 64);
#pragma unroll
                for (int tt = 0; tt < 4; ++tt) {
                    const bf16x8 q0 = ldt(tB, 16 * tt + lr, 16 * lq), q1 = ldt(tB, 16 * tt + lr, 16 * lq + 64);
                    f4 acc = mfma16(a0, q0, (f4){0.f, 0.f, 0.f, 0.f}); acc = mfma16(a1, q1, acc);
                    const int sb = 16 * st + 4 * lq, tc = 16 * tt + lr;
                    if (m < 2) { acc.x = (sb + 0 < tc) ? acc.x : 0.f; acc.y = (sb + 1 < tc) ? acc.y : 0.f; acc.z = (sb + 2 < tc) ? acc.z : 0.f; acc.w = (sb + 3 < tc) ? acc.w : 0.f; }
                    else       { acc.x = (sb + 0 <= tc) ? acc.x : 0.f; acc.y = (sb + 1 <= tc) ? acc.y : 0.f; acc.z = (sb + 2 <= tc) ? acc.z : 0.f; acc.w = (sb + 3 <= tc) ? acc.w : 0.f; }
                    if (m == 0) *(LAS f4*)(NT + tc * 64 + sb) = acc;
                    else if (m == 1) { MK[(sb + 0) * 65 + tc] = acc.x; MK[(sb + 1) * 65 + tc] = acc.y; MK[(sb + 2) * 65 + tc] = acc.z; MK[(sb + 3) * 65 + tc] = acc.w; }
                    else if (m == 2) *(u2*)(PBT + (size_t)task * 4096 + tc * 64 + sb) = pack4(acc);
                    else *(u2*)(PKT + (size_t)task * 4096 + tc * 64 + sb) = pack4(acc);
                }
            }
        }
        __syncthreads();
        if (task + nvb < 2048) PRE_FETCH(task + nvb);
        if (wave < 2) {
            float x[64];
            if (wave == 0) {
#pragma unroll
                for (int i = 0; i < 64; ++i) x[i] = bf2f(*(const LAS bf16*)(tAT + i * TS + lane * 2));
            } else {
#pragma unroll
                for (int i = 0; i < 64; ++i) x[i] = MK[lane * 65 + i];
            }
#pragma unroll
            for (int i = 1; i < 64; ++i) {
                float sacc = x[i];
#pragma unroll
                for (int s4 = 0; s4 < (i + 3) / 4; ++s4) { const f4 n = *(const LAS f4*)(NT + i * 64 + 4 * s4); sacc += (x[4 * s4] * n.x + x[4 * s4 + 1] * n.y) + (x[4 * s4 + 2] * n.z + x[4 * s4 + 3] * n.w); }
                x[i] = sacc;
            }
            if (wave == 0) {
#pragma unroll
                for (int i = 0; i < 64; ++i) KKa[(size_t)(t0 + i) * DR + cb + lane] = (bf16)f2bf(x[i]);
            } else {
#pragma unroll
                for (int i = 0; i < 64; ++i) MKTT[(size_t)task * 4096 + i * 64 + lane] = (bf16)f2bf(x[i]);
            }
        } else {
            for (int p = tid - 128; p < 1024; p += 384) {
                const int mat = p >> 9, k = (p >> 3) & 63, s8 = (p & 7) * 8;
                const LAS unsigned char* tile = mat ? tKT : tBT; const float g = __expf(LG[63 * 64 + k]);
                float v[8];
#pragma unroll
                for (int jx = 0; jx < 8; ++jx) v[jx] = bf2f(*(const LAS bf16*)(tile + (s8 + jx) * TS + k * 2)) * g;
                u4 o; o.x = pg8::cvt_pk_bf16(v[0], v[1]); o.y = pg8::cvt_pk_bf16(v[2], v[3]); o.z = pg8::cvt_pk_bf16(v[4], v[5]); o.w = pg8::cvt_pk_bf16(v[6], v[7]);
                *(u4*)((mat ? Ka : Ba) + (size_t)(t0 + k) * DR + cb + s8) = o;
            }
        }
    }
    __syncthreads();
}

__device__ __forceinline__ void rwkv_seq(const Ctx& c, LAS unsigned char* lds, int bh, int vq) {
    const int tid = opaque_tid(), lane = tid & 63, wave = tid >> 6, lr = lane & 15, lq = lane >> 4;
    constexpr int T_AH = 0, T_MK = 9216, T_RT = 18432, T_PB = 27648, T_PK = 36864, T_BH = 46080, T_KH = 55296, T_VT = 64512, GCL = 73728, SB = 74240, UB = 83456;
    unsigned char* ws = c.ws;
    const bf16* Ra = (const bf16*)(ws + WS_R); const bf16* Ka = (const bf16*)(ws + WS_K); const bf16* Va = (const bf16*)(ws + WS_V); const bf16* KKa = (const bf16*)(ws + WS_KK); const bf16* Ba = (const bf16*)(ws + WS_B);
    const bf16* PBT = (const bf16*)(ws + WS_PBT); const bf16* PKT = (const bf16*)(ws + WS_PKT); const bf16* MKTT = (const bf16*)(ws + WS_MKTT); const float* GC = (const float*)(ws + WS_GC);
    float* Y = (float*)(ws + WS_Y);
    const int b = bh >> 3, hh = bh & 7, cb = hh * 64; const size_t tbase = (size_t)b * SEQ;
    const int row = tid >> 3, c8 = (tid & 7) * 8;
    constexpr int YL = 92672;
    const int t128 = tid & 127;
    u4 q0[4], q1[4], q2[4], q3[4], q4[4], q5[4], q6[4], q7[4]; f4 ag = (f4){0.f, 0.f, 0.f, 0.f};
#define RW_ISSUE(ck_) do { _Pragma("unroll") for (int i_ = 0; i_ < 4; ++i_) { const int p_ = t128 + 128 * i_, row_ = p_ >> 3, c8_ = (p_ & 7) * 8; \
        const size_t go_ = (tbase + (size_t)(ck_) * 64 + row_) * DR + cb + c8_; const size_t to_ = (size_t)(bh * 128 + (ck_)) * 4096 + p_ * 8; \
        q0[i_] = *(const u4*)(KKa + go_); q1[i_] = *(const u4*)(MKTT + to_); q2[i_] = *(const u4*)(Ra + go_); q3[i_] = *(const u4*)(PBT + to_); q4[i_] = *(const u4*)(PKT + to_); \
        q5[i_] = *(const u4*)(Ba + go_); q6[i_] = *(const u4*)(Ka + go_); \
        q7[i_] = *(const u4*)(Va + (tbase + (size_t)(ck_) * 64 + (p_ & 63)) * DR + cb + (p_ >> 6) * 8); } \
        if (t128 < 16) ag = *(const f4*)(GC + (size_t)(bh * 128 + (ck_)) * 64 + t128 * 4); } while (0)
#define RW_COMMIT() do { _Pragma("unroll") for (int i_ = 0; i_ < 4; ++i_) { const int p_ = t128 + 128 * i_, row_ = p_ >> 3, c8_ = (p_ & 7) * 8; const int o = row_ * TS + c8_ * 2; \
        *(LAS u4*)(lds + T_AH + o) = q0[i_]; *(LAS u4*)(lds + T_MK + o) = q1[i_]; *(LAS u4*)(lds + T_RT + o) = q2[i_]; *(LAS u4*)(lds + T_PB + o) = q3[i_]; \
        *(LAS u4*)(lds + T_PK + o) = q4[i_]; *(LAS u4*)(lds + T_BH + o) = q5[i_]; *(LAS u4*)(lds + T_KH + o) = q6[i_]; \
        LAS unsigned char* vt = lds + T_VT + ((p_ >> 6) * 8) * TS + (p_ & 63) * 2; const u4 vv_ = q7[i_]; \
        *(LAS bf16*)(vt + 0 * TS) = (bf16)(vv_.x & 0xffffu); *(LAS bf16*)(vt + 1 * TS) = (bf16)(vv_.x >> 16); *(LAS bf16*)(vt + 2 * TS) = (bf16)(vv_.y & 0xffffu); *(LAS bf16*)(vt + 3 * TS) = (bf16)(vv_.y >> 16); \
        *(LAS bf16*)(vt + 4 * TS) = (bf16)(vv_.z & 0xffffu); *(LAS bf16*)(vt + 5 * TS) = (bf16)(vv_.z >> 16); *(LAS bf16*)(vt + 6 * TS) = (bf16)(vv_.w & 0xffffu); *(LAS bf16*)(vt + 7 * TS) = (bf16)(vv_.w >> 16); } \
        if (t128 < 16) *(LAS f4*)(lds + GCL + t128 * 16) = ag; } while (0)
#define RW_YOUT(ck_) do { const LAS float* yl_ = (const LAS float*)(lds + YL + ((ck_) & 1) * 16384); float* yg_ = Y + (tbase + (size_t)(ck_) * 64) * DR + cb; \
        _Pragma("unroll") for (int i_ = 0; i_ < 8; ++i_) { const int e_ = t128 + 128 * i_, tr_ = e_ >> 4, c4_ = (e_ & 15) * 4; *(f4*)(yg_ + (size_t)tr_ * DR + c4_) = *(const LAS f4*)(yl_ + tr_ * 64 + c4_); } } while (0)
    f4 S[4];
#pragma unroll
    for (int i = 0; i < 4; ++i) S[i] = (f4){0.f, 0.f, 0.f, 0.f};
    const int vb = vq * 16;
#define RW_BAR() do { LDS_FENCE(); __builtin_amdgcn_s_barrier(); } while (0)
    if (wave >= 4) {
        const int par = (wave >= 6) ? 1 : 0;
        RW_ISSUE(par);
#pragma unroll 1
        for (int ck = 0; ck < 128; ++ck) {
            RW_BAR();
            if ((ck & 1) == par) { RW_COMMIT();
#ifdef DUP_COMMIT
            LDS_FENCE(); RW_COMMIT();
#endif
            }
            RW_BAR();
            if ((ck & 1) == par && ck + 2 < 128) RW_ISSUE(ck + 2);
        }
        RW_BAR();
    } else if (wave != 0) {
#pragma unroll 1
        for (int ck = 0; ck < 128; ++ck) { RW_BAR(); RW_BAR(); }
        RW_BAR();
    } else {
#pragma unroll 1
        for (int ck = 0; ck < 128; ++ck) {
            RW_BAR(); RW_BAR();
            bf16x8 af[24];
#pragma unroll
            for (int tt = 0; tt < 4; ++tt) { af[4 * tt] = ldt(lds + T_AH, 16 * tt + lr, 16 * lq); af[4 * tt + 1] = ldt(lds + T_AH, 16 * tt + lr, 16 * lq + 64);
                                             af[4 * tt + 2] = ldt(lds + T_MK, 16 * tt + lr, 16 * lq); af[4 * tt + 3] = ldt(lds + T_MK, 16 * tt + lr, 16 * lq + 64); }
            const bf16x8 vt0 = ldt(lds + T_VT, vb + lr, 16 * lq), vt1 = ldt(lds + T_VT, vb + lr, 16 * lq + 64);
#pragma unroll
            for (int kt = 0; kt < 4; ++kt) *(LAS u2*)(lds + SB + (vb + lr) * TS + (16 * kt + 4 * lq) * 2) = pack4(S[kt]);
            const bf16x8 sb0 = ldt(lds + SB, vb + lr, 16 * lq), sb1 = ldt(lds + SB, vb + lr, 16 * lq + 64);
            __builtin_amdgcn_sched_barrier(0);
            f4 u[4];
#pragma unroll
            for (int tt = 0; tt < 4; ++tt) {
                f4 acc = mfma16(af[4 * tt], sb0, (f4){0.f, 0.f, 0.f, 0.f});
                acc = mfma16(af[4 * tt + 1], sb1, acc);
                acc = mfma16(af[4 * tt + 2], vt0, acc);
                acc = mfma16(af[4 * tt + 3], vt1, acc);
                u[tt] = acc;
            }
            __builtin_amdgcn_sched_barrier(0);
#pragma unroll
            for (int tt = 0; tt < 4; ++tt) { af[6 * tt] = ldt(lds + T_RT, 16 * tt + lr, 16 * lq); af[6 * tt + 1] = ldt(lds + T_RT, 16 * tt + lr, 16 * lq + 64);
                                             af[6 * tt + 2] = ldt(lds + T_PB, 16 * tt + lr, 16 * lq); af[6 * tt + 3] = ldt(lds + T_PB, 16 * tt + lr, 16 * lq + 64);
                                             af[6 * tt + 4] = ldt(lds + T_PK, 16 * tt + lr, 16 * lq); af[6 * tt + 5] = ldt(lds + T_PK, 16 * tt + lr, 16 * lq + 64); }
#pragma unroll
            for (int tt = 0; tt < 4; ++tt) *(LAS u2*)(lds + UB + (vb + lr) * TS + (16 * tt + 4 * lq) * 2) = pack4(u[tt]);
            const bf16x8 ub0 = ldt(lds + UB, vb + lr, 16 * lq), ub1 = ldt(lds + UB, vb + lr, 16 * lq + 64);
            __builtin_amdgcn_sched_barrier(0);
            f4 yv[4];
#pragma unroll
            for (int tt = 0; tt < 4; ++tt) {
                f4 acc = mfma16(af[6 * tt], sb0, (f4){0.f, 0.f, 0.f, 0.f});
                acc = mfma16(af[6 * tt + 1], sb1, acc);
                acc = mfma16(af[6 * tt + 2], ub0, acc);
                acc = mfma16(af[6 * tt + 3], ub1, acc);
                acc = mfma16(af[6 * tt + 4], vt0, acc);
                acc = mfma16(af[6 * tt + 5], vt1, acc);
                yv[tt] = acc;
            }
            __builtin_amdgcn_sched_barrier(0);
            f4 gq[4];
#pragma unroll
            for (int kt = 0; kt < 4; ++kt) { af[4 * kt] = ldt(lds + T_BH, 16 * kt + lr, 16 * lq); af[4 * kt + 1] = ldt(lds + T_BH, 16 * kt + lr, 16 * lq + 64);
                                             af[4 * kt + 2] = ldt(lds + T_KH, 16 * kt + lr, 16 * lq); af[4 * kt + 3] = ldt(lds + T_KH, 16 * kt + lr, 16 * lq + 64);
                                             gq[kt] = *(const LAS f4*)(lds + GCL + (16 * kt + 4 * lq) * 4); }
#pragma unroll
            for (int tt = 0; tt < 4; ++tt) { float* yp = Y + (tbase + (size_t)ck * 64 + 16 * tt + 4 * lq) * DR + cb + vb + lr; yp[0] = yv[tt].x; yp[DR] = yv[tt].y; yp[2 * DR] = yv[tt].z; yp[3 * DR] = yv[tt].w; }
            __builtin_amdgcn_sched_barrier(0);
#pragma unroll
            for (int kt = 0; kt < 4; ++kt) {
                f4 acc = S[kt] * gq[kt];
                acc = mfma16(af[4 * kt], ub0, acc);
                acc = mfma16(af[4 * kt + 1], ub1, acc);
                acc = mfma16(af[4 * kt + 2], vt0, acc);
                acc = mfma16(af[4 * kt + 3], vt1, acc);
                S[kt] = acc;
            }
        }
        RW_BAR();
    }
#undef RW_BAR
#undef RW_ISSUE
#undef RW_COMMIT
#undef RW_YOUT
    __syncthreads();
}

__device__ __forceinline__ void rwkv_post(const Ctx& c, int vb, int nvb) {
    const int tid = opaque_tid();
    unsigned char* ws = c.ws;
    const float* Y = (const float*)(ws + WS_Y); const bf16* Va = (const bf16*)(ws + WS_V); const bf16* Ga = (const bf16*)(ws + WS_G); const float* RK = (const float*)(ws + WS_RK);
    bf16* OB = (bf16*)(ws + WS_OB);
#pragma unroll 1
    for (int pair = vb * NTHREADS + tid; pair < T * 8; pair += nvb * NTHREADS) {
        const int h = pair & 7; const size_t o = (size_t)(pair >> 3) * DR + h * 64;
        f4 y[16]; float s1 = 0.f;
#pragma unroll
        for (int i = 0; i < 16; ++i) { y[i] = *(const f4*)(Y + o + 4 * i); s1 += (y[i].x + y[i].y) + (y[i].z + y[i].w); }
        const float mean = s1 * (1.0f / 64.0f); float s2 = 0.f;
#pragma unroll
        for (int i = 0; i < 16; ++i) { y[i] = y[i] - mean; s2 += (y[i].x * y[i].x + y[i].y * y[i].y) + (y[i].z * y[i].z + y[i].w * y[i].w); }
        const float rstd = __builtin_amdgcn_rsqf(s2 * (1.0f / 64.0f) + 64e-5f), rk = RK[pair];
#pragma unroll
        for (int i = 0; i < 16; ++i) {
            const f4 lg = *(const f4*)(c.in[22] + h * 64 + 4 * i), lb = *(const f4*)(c.in[23] + h * 64 + 4 * i);
            const f4 v = unpack4(*(const u2*)(Va + o + 4 * i)), g = unpack4(*(const u2*)(Ga + o + 4 * i));
            *(u2*)(OB + o + 4 * i) = pack4p((y[i] * rstd * lg + lb + v * rk) * g);
        }
    }
}

__device__ __forceinline__ void final_norm(const Ctx& c, int vb, int nvb) {
    const int tid = opaque_tid(), lane = tid & 63, wave = tid >> 6;
    const int gw = vb * NWAVES + wave, NGW = nvb * NWAVES;
    const float* rowsq = (const float*)(c.ws + WS_ROWSQ2); const float* gf = c.in[29]; const bf16* X2 = (const bf16*)(c.ws + WS_X1);
    f4 gv[4];
#pragma unroll
    for (int j = 0; j < 2; ++j) { gv[2 * j] = *(const f4*)(gf + 512 * j + 8 * lane); gv[2 * j + 1] = *(const f4*)(gf + 512 * j + 8 * lane + 4); }
#pragma unroll 4
    for (int m = gw; m < T; m += NGW) {
        const float rs = __builtin_amdgcn_rsqf(rowsq[m] * (1.0f / DM) + 1e-6f);
        const bf16* xr = X2 + (size_t)m * DM + 8 * lane; float* orow = c.out + (size_t)m * DM + 8 * lane;
#pragma unroll
        for (int j = 0; j < 2; ++j) { f4 a, b; unpack8(*(const u4*)(xr + 512 * j), a, b); *(f4*)(orow + 512 * j) = a * rs * gv[2 * j]; *(f4*)(orow + 512 * j + 4) = b * rs * gv[2 * j + 1]; }
    }
}

__global__ void __launch_bounds__(NTHREADS, 2) mk_fwd(Args args) {
    extern __shared__ __attribute__((aligned(16))) unsigned char lds_raw[];
    LAS unsigned char* lds = (LAS unsigned char*)lds_raw;
    cg::grid_group grid = cg::this_grid();
    Ctx c; c.in = args.in; c.out = args.out; c.ws = args.ws;
    unsigned char* ws = args.ws;
    const int G = gridDim.x, bx = blockIdx.x;
    const int lo = args.ph_lo, hi = args.ph_hi;
#define IN(k) (lo <= (k) && (k) < hi)
#define SEAM(k) do { if (IN(k) && IN((k) + 1)) { if ((k) == 0) grid_barrier_census((unsigned*)(ws + WS_BAR), (unsigned)G, (volatile LAS unsigned*)(lds + 131072)); \
        else grid_barrier_xcd((unsigned*)(ws + WS_BAR), (k), (volatile LAS unsigned*)(lds + 131072)); } } while (0)
    if (args.ph_lo > 1000) grid.sync();
#ifndef REP_P1
#define REP_P1 1
#endif
#ifndef REP_P2
#define REP_P2 1
#endif
#ifndef REP_P3
#define REP_P3 1
#endif
#ifndef REP_P4
#define REP_P4 1
#endif
#ifndef REP_P5
#define REP_P5 1
#endif
#ifndef REP_P7
#define REP_P7 1
#endif
#ifndef REP_P0
#define REP_P0 1
#endif
    bf16* H = (bf16*)(ws + WS_H);

        for (int rep = 0; rep < REP_P0; ++rep) { if (rep) grid.sync();
    if (IN(0)) { p0_prologue(c, lds, bx, G); }
#ifdef DUP_P0
    if (IN(0)) { p0_prologue(c, lds, bx, G); }
#endif
    }
    SEAM(0);
    for (int rep = 0; rep < REP_P1; ++rep) { if (rep) grid.sync();
    if (IN(1)) { EpiProj E{(bf16*)((unsigned char*)args.out + DO_U), (bf16*)(ws + WS_P)}; run_gemm(lds, H, (const bf16*)(ws + WS_WIN), 2304, 1024, E, bx, G);
                 if (bx >= 576 - 2 * G && G > 64) p0_weights_late(c, lds, bx - (576 - 2 * G), G - (576 - 2 * G)); }
#ifdef DUP_P1
    if (IN(1)) { EpiProj E{(bf16*)((unsigned char*)args.out + DO_U), (bf16*)(ws + WS_P)}; run_gemm(lds, H, (const bf16*)(ws + WS_WIN), 2304, 1024, E, bx, G); }
#endif
    }
    SEAM(1);
    if (IN(2)) {
        rwkv_prep(c, lds, bx, G);
        s5_passA(c, lds, bx, G);
    }
#ifdef DUP_PREP
    if (IN(2)) { rwkv_prep(c, lds, bx, G); }
#endif
#ifdef DUP_S5A
    if (IN(2)) { s5_passA(c, lds, bx, G); }
#endif
    SEAM(2);
    if (IN(3)) { rwkv_pre(c, lds, bx, G); }
    SEAM(3);
    for (int rep = 0; rep < REP_P3; ++rep) { if (rep) grid.sync();
    if (IN(4)) {
#ifndef NO_REC
#ifndef REP_SEQ
#define REP_SEQ 1
#endif
        if (bx < NREC) for (int r6 = 0; r6 < REP_SEQ; ++r6) rwkv_seq(c, lds, bx >> 2, bx & 3);
#endif
#ifndef NO_S5C
#ifndef REP_S5C
#define REP_S5C 1
#endif
        if (bx >= NREC) for (int r5 = 0; r5 < REP_S5C; ++r5) s5_passC(c, lds, bx - NREC, G - NREC);
#endif
    }
    }
    SEAM(4);
    for (int rep = 0; rep < REP_P4; ++rep) { if (rep) grid.sync();
    if (IN(5)) {
        EpiGlu E{(const bf16*)((unsigned char*)args.out + DO_Z), args.in[12], (bf16*)((unsigned char*)args.out + DO_OA)};
        run_gemm(lds, (const bf16*)((unsigned char*)args.out + DO_Z), (const bf16*)(ws + WS_WGLU), 512, 512, E, bx, G);
        rwkv_post(c, bx, G);
    }
#ifdef DUP_P5
    if (IN(5)) {
        EpiGlu E{(const bf16*)((unsigned char*)args.out + DO_Z), args.in[12], (bf16*)((unsigned char*)args.out + DO_OA)};
        run_gemm(lds, (const bf16*)((unsigned char*)args.out + DO_Z), (const bf16*)(ws + WS_WGLU), 512, 512, E, bx, G);
        rwkv_post(c, bx, G);
    }
#endif
    }
    SEAM(5);
    for (int rep = 0; rep < REP_P5; ++rep) { if (rep) grid.sync();
    if (IN(6)) {
        { EpiGateA E{(bf16*)(ws + WS_T1)}; run_gemm(lds, H, (const bf16*)(ws + WS_WIN) + (size_t)2304 * 1024, 1024, 1024, E, bx, G); }
        { EpiMulA E{(bf16*)(ws + WS_T1)}; run_gemm(lds, (const bf16*)((unsigned char*)args.out + DO_OA), (const bf16*)(ws + WS_WBA), 1024, 512, E, bx, G); }
        { EpiGateB E{(bf16*)(ws + WS_T2)}; run_gemm(lds, H, (const bf16*)(ws + WS_WIN) + (size_t)3328 * 1024, 1024, 1024, E, bx, G); }
        { EpiMerge E{(const bf16*)(ws + WS_T1), (const bf16*)(ws + WS_T2), (bf16*)(ws + WS_MERGED)}; run_gemm(lds, (const bf16*)(ws + WS_OB), (const bf16*)(ws + WS_WBB), 1024, 512, E, bx, G); }
    }
#ifdef DUP_P6
    if (IN(6)) {
        { EpiGateA E{(bf16*)(ws + WS_T1)}; run_gemm(lds, H, (const bf16*)(ws + WS_WIN) + (size_t)2304 * 1024, 1024, 1024, E, bx, G); }
        { EpiMulA E{(bf16*)(ws + WS_T1)}; run_gemm(lds, (const bf16*)((unsigned char*)args.out + DO_OA), (const bf16*)(ws + WS_WBA), 1024, 512, E, bx, G); }
        { EpiGateB E{(bf16*)(ws + WS_T2)}; run_gemm(lds, H, (const bf16*)(ws + WS_WIN) + (size_t)3328 * 1024, 1024, 1024, E, bx, G); }
        { EpiMerge E{(const bf16*)(ws + WS_T1), (const bf16*)(ws + WS_T2), (bf16*)(ws + WS_MERGED)}; run_gemm(lds, (const bf16*)(ws + WS_OB), (const bf16*)(ws + WS_WBB), 1024, 512, E, bx, G); }
    }
#endif
    }
    SEAM(6);
    if (IN(7)) { EpiWout E{args.in[0], args.in[26], (bf16*)(ws + WS_X1), (bf16*)(ws + WS_XG), (float*)(ws + WS_ROWSQ1)}; run_gemm(lds, (const bf16*)(ws + WS_MERGED), (const bf16*)(ws + WS_WOUT), 1024, 1024, E, bx, G); }
    SEAM(7);
    for (int rep = 0; rep < REP_P7; ++rep) { if (rep) grid.sync();
    if (IN(8)) { EpiFF1 E{(const float*)(ws + WS_ROWSQ1), (bf16*)(ws + WS_F)}; run_gemm(lds, (const bf16*)(ws + WS_XG), (const bf16*)(ws + WS_W1), 4096, 1024, E, bx, G); }
#ifdef DUP_FF1
    if (IN(8)) { EpiFF1 E{(const float*)(ws + WS_ROWSQ1), (bf16*)(ws + WS_F)}; run_gemm(lds, (const bf16*)(ws + WS_XG), (const bf16*)(ws + WS_W1), 4096, 1024, E, bx, G); }
#endif
    }
    SEAM(8);
    if (IN(9)) { EpiFF2 E{(bf16*)(ws + WS_X1), (float*)(ws + WS_ROWSQ2)}; run_gemm(lds, (const bf16*)(ws + WS_F), (const bf16*)(ws + WS_W2), 1024, 4096, E, bx, G); }
    SEAM(9);
    if (IN(10)) { final_norm(c, bx, G); }
#ifdef EXTRA_SYNCS
    for (int i = 0; i < EXTRA_SYNCS; ++i) grid_barrier_xcd((unsigned*)(ws + WS_BAR), 11 + i, (volatile LAS unsigned*)(lds + 131072));
#endif
#undef IN
#undef SEAM
}

extern "C" void kernel_launch(void* const* d_in, const int* in_sizes, int n_in, void* d_out, int out_size, void* d_ws, size_t ws_size, hipStream_t stream) {
    static int grid = 0;
    if (grid == 0) {
        if (n_in != 30 || out_size != T * DM || ws_size < WS_END) { fprintf(stderr, "kernel_launch: unexpected shapes (n_in %d out %d ws %zu)\n", n_in, out_size, ws_size); grid = -1; return; }
        int dev = 0, cus = 0, per_cu = 0;
        hipGetDevice(&dev); hipDeviceGetAttribute(&cus, hipDeviceAttributeMultiprocessorCount, dev);
        if (hipFuncSetAttribute((const void*)mk_fwd, hipFuncAttributeMaxDynamicSharedMemorySize, LDS_BYTES) != hipSuccess) { fprintf(stderr, "kernel_launch: hipFuncSetAttribute failed\n"); grid = -1; return; }
        if (hipOccupancyMaxActiveBlocksPerMultiprocessor(&per_cu, (const void*)mk_fwd, NTHREADS, LDS_BYTES) != hipSuccess || per_cu < 1) { fprintf(stderr, "kernel_launch: occupancy query failed (%d)\n", per_cu); (void)hipGetLastError(); per_cu = 1; }
        grid = cus * (per_cu > 1 ? 1 : per_cu);
        if (grid < 2 * NREC) { fprintf(stderr, "kernel_launch: grid %d too small\n", grid); grid = -1; return; }
    }
    if (grid < 0) return;
    if (hipMemsetAsync((char*)d_ws + WS_BAR, 0, WS_BAR_BYTES, stream) != hipSuccess) { fprintf(stderr, "kernel_launch: memset of the barrier words failed\n"); return; }
    Args a{};
    for (int i = 0; i < 30; ++i) a.in[i] = (const float*)d_in[i];
    a.out = (float*)d_out; a.ws = (unsigned char*)d_ws;
#if MK_LAUNCHES == 1
    a.ph_lo = 0; a.ph_hi = NPHASES;
    void* kargs[] = {&a};
    hipError_t e = hipLaunchCooperativeKernel((const void*)mk_fwd, dim3(grid), dim3(NTHREADS), kargs, LDS_BYTES, stream);
    if (e != hipSuccess) fprintf(stderr, "cooperative launch failed: %s (grid %d)\n", hipGetErrorString(e), grid);
#else
    for (int p = 0; p < NPHASES; ++p) { a.ph_lo = p; a.ph_hi = p + 1; hipLaunchKernelGGL(mk_fwd, dim3(grid), dim3(NTHREADS), LDS_BYTES, stream, a); }
#endif
}
```

```cpp
#include <hip/hip_runtime.h>
#include <hip/hip_cooperative_groups.h>
#include <cstdio>
#include <cstdint>
namespace cg = cooperative_groups;
namespace pg8 {
#define PG8_LAS __attribute__((address_space(3)))
typedef unsigned short bf16_t;
typedef short bf16x8 __attribute__((ext_vector_type(8)));
typedef float f32x4 __attribute__((ext_vector_type(4)));
typedef unsigned u32x4 __attribute__((ext_vector_type(4)));
constexpr int BM = 256, BK = 64, HALF = 128, HTB = HALF * BK * 2  , STAGE_BYTES = 8 * HTB, NXCD = 8, WGM = 8;

__host__ __device__ __forceinline__ int lds_byte(int r, int c) { const int st = (r >> 4) * 2 + (c >> 5), rr = r & 15, cc = c & 31, ob = rr * 64 + cc * 2; return st * 1024 + (ob ^ (((ob >> 9) & 1) << 5)); }
__host__ __device__ __forceinline__ void stage_rc(int b, int& R, int& C) { const int st = b / 1024, sb = b % 1024, swz = sb ^ (((sb >> 9) & 1) << 5); R = (st >> 1) * 16 + swz / 64; C = (st & 1) * 32 + (swz % 64) / 2; }
__host__ __device__ __forceinline__ int perm32(int rho) { const int n = rho >> 4, i = rho & 15; return 8 * (i >> 2) + 4 * n + (i & 3); }

struct Unit { int pm, pn; };
struct Gemm { const bf16_t* A; const bf16_t* Bt; int M, N, K; };

struct StaticOrder {
    int nM, nN, nwg, G, c;
    __host__ __device__ void init(int M, int N, int G_, int c_) { nM = M / BM; nN = N / BM; nwg = nM * nN; G = G_; c = c_; }
    __host__ __device__ bool next(int i, Unit& u) const {
        const long L = (long)i * G + c; if (L >= nwg) return false;
        int wgid = (int)L; { const int q = nwg / NXCD, r = nwg % NXCD, xcd = wgid % NXCD, off = wgid / NXCD; wgid = (xcd < r ? xcd * (q + 1) : r * (q + 1) + (xcd - r) * q) + off; }
        const int nig = WGM * nN, gid = wgid / nig, fm = gid * WGM, gsz = (nM - fm) < WGM ? (nM - fm) : WGM;
        u.pm = fm + ((wgid % nig) % gsz); u.pn = (wgid % nig) / gsz; return true;
    }
    __device__ __forceinline__ void a_ready(const Unit&) const {}
    __device__ __forceinline__ void done(const Unit&) const {}
};

__device__ __forceinline__ unsigned cvt_pk_bf16(float lo, float hi) { unsigned r; asm volatile("v_cvt_pk_bf16_f32 %0, %1, %2" : "=v"(r) : "v"(lo), "v"(hi)); return r; }
template <class Epi, class Sched, bool ALIGN_EPI = false, bool SP2 = false>
__device__ __forceinline__ void gemm_phase(PG8_LAS unsigned char* lds, const Gemm g, const Sched& S, const Epi& E) {
    int tid_ = threadIdx.x; asm volatile("" : "+v"(tid_));
    const int tid = tid_, wid = __builtin_amdgcn_readfirstlane(tid >> 6), lane = tid & 63, wr = wid >> 2, wc = wid & 3, fr = lane & 15, fq = lane >> 4;
    const int K = g.K, nt = K / BK;
    unsigned voffA[2], voffB[2];
#pragma unroll
    for (int i = 0; i < 2; ++i) { int R, C; stage_rc(tid * 16 + i * 8192, R, C); const int Rb = Epi::PERM ? ((R & ~31) + perm32(R & 31)) : R;
        voffA[i] = (unsigned)(R * K + C) * 2u; voffB[i] = (unsigned)(Rb * K + C) * 2u; }
    const size_t kstep = (size_t)(BK * 2);
    const size_t hstep = (size_t)HALF * K * 2;
    const size_t tstep = 2 * hstep;
    const unsigned ldsw = (unsigned)wid * 1024u;
    const int aoff = lds_byte(wr * 64 + fr, fq * 8), boff = lds_byte(wc * 32 + fr, fq * 8);
#define PG8_SA(b, h) (((b) * 2 + (h)) * HTB)
#define PG8_SB(b, h) ((4 + (b) * 2 + (h)) * HTB)
#define PG8_STAGE(bufoff, gbase, voff) do { _Pragma("unroll") for (int _i = 0; _i < 2; ++_i) \
        __builtin_amdgcn_global_load_lds((const unsigned*)((const char*)(gbase) + (voff)[_i]), (PG8_LAS unsigned*)(lds + (bufoff) + ldsw + _i * 8192), 16, 0, 0); } while (0)
#define PG8_LDA(dst, b, h) do { _Pragma("unroll") for (int m = 0; m < 4; ++m) _Pragma("unroll") for (int k = 0; k < 2; ++k) dst[m][k] = *(const PG8_LAS bf16x8*)(lds + PG8_SA(b, h) + aoff + m * 2048 + k * 1024); } while (0)
#define PG8_LDB(dst, b, h) do { _Pragma("unroll") for (int n = 0; n < 2; ++n) _Pragma("unroll") for (int k = 0; k < 2; ++k) dst[n][k] = *(const PG8_LAS bf16x8*)(lds + PG8_SB(b, h) + boff + n * 2048 + k * 1024); } while (0)
#define PG8_MMA(ai, bj, At, Bt) do { __builtin_amdgcn_s_setprio(1); _Pragma("unroll") for (int m = 0; m < 4; ++m) _Pragma("unroll") for (int n = 0; n < 2; ++n) _Pragma("unroll") for (int k = 0; k < 2; ++k) \
        acc[ai][bj][m][n] = __builtin_amdgcn_mfma_f32_16x16x32_bf16(Bt[n][k], At[m][k], acc[ai][bj][m][n], 0, 0, 0); __builtin_amdgcn_s_setprio(0); } while (0)
#define PG8_WAIT_V(n) asm volatile("s_waitcnt vmcnt(" #n ")" ::: "memory")
#define PG8_WAIT_L(n) asm volatile("s_waitcnt lgkmcnt(" #n ")" ::: "memory")
#define PG8_BAR __builtin_amdgcn_s_barrier()
#define PG8_SCHED __builtin_amdgcn_sched_barrier(0)
    Unit cur, nxt; int ui = 0;
    if (!S.next(0, cur)) return;
    f32x4 acc[2][2][4][2];
#pragma unroll
    for (int a = 0; a < 2; ++a)
#pragma unroll
        for (int b = 0; b < 2; ++b)
#pragma unroll
            for (int m = 0; m < 4; ++m)
#pragma unroll
                for (int n = 0; n < 2; ++n) acc[a][b][m][n] = (f32x4){0.f, 0.f, 0.f, 0.f};
    bf16x8 At[4][2], B0[2][2], B1[2][2];
    const char* cA = (const char*)g.A + (size_t)cur.pm * tstep; const char* cB = (const char*)g.Bt + (size_t)cur.pn * tstep;
    S.a_ready(cur);
    if constexpr (SP2) {
        PG8_STAGE(PG8_SB(0, 0), cB, voffB); PG8_STAGE(PG8_SB(0, 1), cB + hstep, voffB); PG8_STAGE(PG8_SA(0, 0), cA, voffA); PG8_STAGE(PG8_SA(0, 1), cA + hstep, voffA);
        if (wr == 1) PG8_BAR;
        PG8_WAIT_V(2); PG8_BAR;
        PG8_STAGE(PG8_SB(1, 0), cB + kstep, voffB); PG8_STAGE(PG8_SA(1, 0), cA + kstep, voffA); PG8_STAGE(PG8_SB(1, 1), cB + hstep + kstep, voffB);
        PG8_WAIT_V(6); PG8_BAR;
    } else {
        PG8_STAGE(PG8_SB(0, 0), cB, voffB); PG8_STAGE(PG8_SA(0, 0), cA, voffA); PG8_STAGE(PG8_SB(0, 1), cB + hstep, voffB); PG8_STAGE(PG8_SA(0, 1), cA + hstep, voffA);
        if (wr == 1) PG8_BAR;
        PG8_WAIT_V(4); PG8_BAR;
        PG8_STAGE(PG8_SB(1, 0), cB + kstep, voffB); PG8_STAGE(PG8_SA(1, 0), cA + kstep, voffA); PG8_STAGE(PG8_SB(1, 1), cB + hstep + kstep, voffB);
        PG8_WAIT_V(6); PG8_BAR;
    }
    for (;;) {
        const bool has_next = S.next(ui + 1, nxt);
        const char* nA = has_next ? (const char*)g.A + (size_t)nxt.pm * tstep : cA; const char* nB = has_next ? (const char*)g.Bt + (size_t)nxt.pn * tstep : cB;
        for (int t = 0; t < nt; t += 2) {
            const bool last = (t == nt - 2);
            const char* a1 = cA + (size_t)(t + 1) * kstep;
            const char* a2 = last ? nA : cA + (size_t)(t + 2) * kstep; const char* b2 = last ? nB : cB + (size_t)(t + 2) * kstep;
            const char* a3 = a2 + kstep; const char* b3 = b2 + kstep;
            if (last && has_next) S.a_ready(nxt);
            if constexpr (SP2) {
            PG8_LDB(B0, 0, 0); PG8_LDB(B1, 0, 1); PG8_SCHED; PG8_LDA(At, 0, 0); PG8_STAGE(PG8_SA(1, 1), a1 + hstep, voffA);
            PG8_WAIT_V(8); PG8_WAIT_L(0); PG8_BAR; PG8_MMA(0, 0, At, B0); PG8_MMA(0, 1, At, B1); PG8_BAR; PG8_SCHED;
            PG8_LDA(At, 0, 1); PG8_STAGE(PG8_SB(0, 0), b2, voffB); PG8_STAGE(PG8_SB(0, 1), b2 + hstep, voffB); PG8_STAGE(PG8_SA(0, 0), a2, voffA);
            PG8_WAIT_V(8); PG8_WAIT_L(0); PG8_BAR; PG8_MMA(1, 0, At, B0); PG8_MMA(1, 1, At, B1); PG8_BAR; PG8_SCHED;
            PG8_LDB(B0, 1, 0); PG8_LDB(B1, 1, 1); PG8_SCHED; PG8_LDA(At, 1, 0); PG8_STAGE(PG8_SA(0, 1), a2 + hstep, voffA);
            PG8_WAIT_V(8); PG8_WAIT_L(0); PG8_BAR; PG8_MMA(0, 0, At, B0); PG8_MMA(0, 1, At, B1); PG8_BAR; PG8_SCHED;
            PG8_LDA(At, 1, 1); PG8_STAGE(PG8_SB(1, 0), b3, voffB); PG8_STAGE(PG8_SB(1, 1), b3 + hstep, voffB); PG8_STAGE(PG8_SA(1, 0), a3, voffA);
            PG8_WAIT_V(8); PG8_WAIT_L(0); PG8_BAR; PG8_MMA(1, 0, At, B0); PG8_MMA(1, 1, At, B1); PG8_BAR; PG8_SCHED;
            } else {
            PG8_LDB(B0, 0, 0); PG8_SCHED; PG8_LDA(At, 0, 0); PG8_STAGE(PG8_SA(1, 1), a1 + hstep, voffA);
            PG8_WAIT_L(8); PG8_BAR; PG8_WAIT_L(0); PG8_MMA(0, 0, At, B0); PG8_BAR; PG8_SCHED;
            PG8_LDB(B1, 0, 1); PG8_STAGE(PG8_SB(0, 0), b2, voffB);
            PG8_BAR; PG8_WAIT_L(0); PG8_MMA(0, 1, At, B1); PG8_BAR;
            PG8_LDA(At, 0, 1); PG8_STAGE(PG8_SA(0, 0), a2, voffA);
            PG8_BAR; PG8_WAIT_L(0); PG8_MMA(1, 0, At, B0); PG8_BAR; PG8_SCHED;
            PG8_STAGE(PG8_SB(0, 1), b2 + hstep, voffB);
            PG8_WAIT_V(6); PG8_BAR; PG8_MMA(1, 1, At, B1); PG8_BAR;
            PG8_LDB(B0, 1, 0); PG8_SCHED; PG8_LDA(At, 1, 0); PG8_STAGE(PG8_SA(0, 1), a2 + hstep, voffA);
            PG8_WAIT_L(8); PG8_BAR; PG8_WAIT_L(0); PG8_MMA(0, 0, At, B0); PG8_BAR; PG8_SCHED;
            PG8_LDB(B1, 1, 1); PG8_STAGE(PG8_SB(1, 0), b3, voffB);
            PG8_BAR; PG8_WAIT_L(0); PG8_MMA(0, 1, At, B1); PG8_BAR;
            PG8_LDA(At, 1, 1); PG8_STAGE(PG8_SA(1, 0), a3, voffA);
            PG8_BAR; PG8_WAIT_L(0); PG8_MMA(1, 0, At, B0); PG8_BAR; PG8_SCHED;
            PG8_STAGE(PG8_SB(1, 1), b3 + hstep, voffB);
            PG8_WAIT_V(6); PG8_BAR; PG8_MMA(1, 1, At, B1); PG8_BAR;
            }
        }
        if constexpr (ALIGN_EPI) { if (wr == 0) PG8_BAR; }
        if constexpr (!Epi::AFTER_DRAIN) { E(acc, cur, wr, wc, fr, fq); S.done(cur); }
        if (!has_next) break;
#pragma unroll
        for (int a = 0; a < 2; ++a)
#pragma unroll
            for (int b = 0; b < 2; ++b)
#pragma unroll
                for (int m = 0; m < 4; ++m)
#pragma unroll
                    for (int n = 0; n < 2; ++n) acc[a][b][m][n] = (f32x4){0.f, 0.f, 0.f, 0.f};
        cur = nxt; cA = nA; cB = nB; ++ui;
        if constexpr (ALIGN_EPI) { if (wr == 1) PG8_BAR; }
    }
    PG8_WAIT_V(0);
    if constexpr (!ALIGN_EPI) { if (wr == 0) PG8_BAR; }
    PG8_BAR;
    if constexpr (Epi::AFTER_DRAIN) { E.fused(acc, cur, wr, wc, fr, fq, lds, wid, lane); S.done(cur); }
#undef PG8_SA
#undef PG8_SB
#undef PG8_STAGE
#undef PG8_LDA
#undef PG8_LDB
#undef PG8_MMA
#undef PG8_WAIT_V
#undef PG8_WAIT_L
#undef PG8_BAR
#undef PG8_SCHED
}
}

#ifndef MK_LAUNCHES
#define MK_LAUNCHES 1
#endif
#define LAS __attribute__((address_space(3)))
typedef unsigned short bf16;
typedef float f4 __attribute__((ext_vector_type(4)));
typedef float f2 __attribute__((ext_vector_type(2)));
typedef unsigned u4 __attribute__((ext_vector_type(4)));
typedef unsigned u2 __attribute__((ext_vector_type(2)));

constexpr int T = 16384, SEQ = 8192, DM = 1024, DS = 512, DR = 512, NP = 1792, DFF = 4096;
constexpr int NTHREADS = 512, NWAVES = 8, LDS_BYTES = 131072 + 64, NPHASES = 11;
constexpr int S5_TC = 64, S5_NCH = SEQ / S5_TC;
constexpr int RW_CH = 32;
constexpr int NREC = 64;
constexpr size_t MiB = 1u << 20;
constexpr size_t WS_ROWSQ1 = 0, WS_ROWSQ2 = 65536, WS_ABAR = 131072, WS_ATC = 147456, WS_BBAR = 163840, WS_CT = 425984;
constexpr size_t WS_BAR = 917504, WS_BAR_BYTES = 32768;
constexpr size_t WS_WIN = 1 * MiB, WS_WGLU = WS_WIN + (size_t)4352 * 1024 * 2, WS_WBA = 10 * MiB, WS_WBB = 11 * MiB, WS_WOUT = 12 * MiB, WS_W1 = 14 * MiB, WS_W2 = 22 * MiB;
constexpr size_t WS_H = 30 * MiB;
constexpr size_t WS_R = 62 * MiB, WS_K = 78 * MiB, WS_V = 94 * MiB, WS_KK = 110 * MiB, WS_P = 126 * MiB, WS_W = 182 * MiB, WS_B = 214 * MiB, WS_G = 230 * MiB, WS_RK = 246 * MiB, WS_E = 247 * MiB;
constexpr size_t WS_PBT = 126 * MiB, WS_PKT = 142 * MiB, WS_MKTT = 158 * MiB, WS_GC = 251 * MiB;
constexpr size_t WS_W2T = 251 * MiB + 512 * 1024, WS_A2T = WS_W2T + 65536, WS_G2T = WS_A2T + 65536;
constexpr size_t WS_CTB = WS_G2T + 131072;
constexpr size_t WS_BBT = WS_CTB + 131072;
constexpr size_t WS_Y = 182 * MiB, WS_OB = 158 * MiB, WS_T1 = 62 * MiB, WS_T2 = 182 * MiB, WS_MERGED = 214 * MiB, WS_X1 = 62 * MiB, WS_XG = 30 * MiB, WS_F = 126 * MiB, WS_END = 254 * MiB;
static_assert(WS_WGLU + 512 * 512 * 2 <= WS_WBA && WS_CT + 32 * 64 * 32 * 4 <= WS_WIN, "ws map");
constexpr size_t DO_U = 0, DO_Z = 32 * MiB, DO_OA = 48 * MiB;

struct Args { const float* in[30]; float* out; unsigned char* ws; int ph_lo, ph_hi; };

struct Ctx {
    const float* const* in; float* out; unsigned char* ws;
};

__device__ __forceinline__ unsigned f2bf(float f) { unsigned u = __builtin_bit_cast(unsigned, f); return (u + 0x7fffu + ((u >> 16) & 1u)) >> 16; }
__device__ __forceinline__ unsigned pk2(float lo, float hi) { return f2bf(lo) | (f2bf(hi) << 16); }
__device__ __forceinline__ float bf2f(bf16 b) { return __builtin_bit_cast(float, (unsigned)b << 16); }
__device__ __forceinline__ float bflo(unsigned u) { return __builtin_bit_cast(float, u << 16); }
__device__ __forceinline__ float bfhi(unsigned u) { return __builtin_bit_cast(float, u & 0xffff0000u); }
__device__ __forceinline__ float sigm(float x) { return __builtin_amdgcn_rcpf(1.0f + __expf(-x)); }
__device__ __forceinline__ float tanh_f(float x) { return 1.0f - 2.0f * __builtin_amdgcn_rcpf(1.0f + __expf(2.0f * x)); }
__device__ __forceinline__ float wave_sum(float v) {
#pragma unroll
    for (int o = 1; o < 64; o <<= 1) v += __shfl_xor(v, o);
    return v;
}
#define LDS_FENCE() asm volatile("s_waitcnt lgkmcnt(0)" ::: "memory")
__device__ __forceinline__ int opaque_tid() { int t = threadIdx.x; asm volatile("" : "+v"(t)); return t; }


constexpr int BW_CENSUS = 0, BW_GLOBAL = 256, BW_XCD = 2048;
__device__ __forceinline__ unsigned xcc_id() { return (unsigned)__builtin_amdgcn_s_getreg((3 << 11) | 20) & 0xFu; }
__device__ __forceinline__ void grid_barrier_census(unsigned* bar, unsigned nblocks, volatile LAS unsigned* st) {
    __syncthreads();
    if (threadIdx.x == 0) {
        const unsigned x = xcc_id();
        __hip_atomic_fetch_add(bar + BW_CENSUS + x, 1u, __ATOMIC_RELAXED, __HIP_MEMORY_SCOPE_AGENT);
        unsigned* p = bar + BW_GLOBAL;
        __hip_atomic_fetch_add(p, 1u, __ATOMIC_RELEASE, __HIP_MEMORY_SCOPE_AGENT);
        unsigned spins = 0;
        while (__hip_atomic_load(p, __ATOMIC_RELAXED, __HIP_MEMORY_SCOPE_AGENT) < nblocks && ++spins < (1u << 22)) __builtin_amdgcn_s_sleep(1);
        __builtin_amdgcn_fence(__ATOMIC_ACQUIRE, "agent");
        unsigned nx = 0, nxcd = 0;
        for (unsigned i = 0; i < 16; ++i) { const unsigned v = __hip_atomic_load(bar + BW_CENSUS + i, __ATOMIC_RELAXED, __HIP_MEMORY_SCOPE_AGENT); nxcd += (v != 0u); if (i == x) nx = v; }
        st[0] = nx; st[1] = nxcd;
    }
    __syncthreads();
}
__device__ __forceinline__ void grid_barrier_xcd(unsigned* bar, int k, volatile LAS unsigned* st) {
    __syncthreads();
    if (threadIdx.x == 0) {
        const unsigned x = xcc_id(), nx = st[0], nxcd = st[1];
        unsigned* g = bar + BW_GLOBAL + 64 * k;
        const unsigned old = __hip_atomic_fetch_add(bar + BW_XCD + (k * 16 + (int)x) * 16, 1u, __ATOMIC_RELAXED, __HIP_MEMORY_SCOPE_AGENT);
        if (old + 1u == nx) { __builtin_amdgcn_fence(__ATOMIC_RELEASE, "agent"); __hip_atomic_fetch_add(g, 1u, __ATOMIC_RELAXED, __HIP_MEMORY_SCOPE_AGENT); }
        unsigned spins = 0;
        while (__hip_atomic_load(g, __ATOMIC_RELAXED, __HIP_MEMORY_SCOPE_AGENT) < nxcd && ++spins < (1u << 22)) __builtin_amdgcn_s_sleep(1);
        __builtin_amdgcn_fence(__ATOMIC_ACQUIRE, "agent");
    }
    __syncthreads();
}

__device__ __forceinline__ void p0_transpose_item(const float* W, int K, int N, bf16* WT, LAS float* scr, int item, int lane, int nb0 = 0, int nbn = 0) {
    const int nblk = nbn ? nbn : N / 32, kb = item / nblk, nb = nb0 + item % nblk, k0 = 64 * kb, n0 = 32 * nb;
    f4 wv_[8];
#pragma unroll
    for (int i = 0; i < 8; ++i) wv_[i] = *(const f4*)(W + (size_t)(k0 + 8 * i + (lane >> 3)) * N + n0 + (lane & 7) * 4);
#pragma unroll
    for (int i = 0; i < 8; ++i) { LAS float* d = scr + (8 * i + (lane >> 3)) * 33 + (lane & 7) * 4; d[0] = wv_[i].x; d[1] = wv_[i].y; d[2] = wv_[i].z; d[3] = wv_[i].w; }
    LDS_FENCE();
    const int c = lane & 7;
#pragma unroll
    for (int j = 0; j < 4; ++j) { const int n = (lane >> 3) + 8 * j; const LAS float* s = scr + (8 * c) * 33 + n;
        u4 o; o.x = pk2(s[0 * 33], s[1 * 33]); o.y = pk2(s[2 * 33], s[3 * 33]); o.z = pk2(s[4 * 33], s[5 * 33]); o.w = pk2(s[6 * 33], s[7 * 33]);
        *(u4*)(WT + (size_t)(n0 + n) * K + k0 + 8 * c) = o; }
    LDS_FENCE();
}

__device__ __forceinline__ void p0_weights_late(const Ctx& c, LAS unsigned char* lds, int vb, int nvb) {
    const int tid = opaque_tid(), lane = tid & 63, wave = tid >> 6;
    LAS float* scr = (LAS float*)(lds + wave * 16384);
    const int gw = vb * NWAVES + wave, NGW = nvb * NWAVES;
    unsigned char* ws = c.ws;
    constexpr int I_INB = 16 * 64, I_GLU = 8 * 16, I_BA = 8 * 32, I_OUT = 16 * 32, I_1 = 16 * 128, I_2 = 64 * 32;
    constexpr int NITEMS = I_INB + I_GLU + 2 * I_BA + I_OUT + I_1 + I_2;
    for (int it = gw; it < NITEMS; it += NGW) {
        int r = it;
        if (r < I_INB) { p0_transpose_item(c.in[2], 1024, 4352, (bf16*)(ws + WS_WIN), scr, r, lane, 72, 64); continue; } r -= I_INB;
        if (r < I_GLU) { p0_transpose_item(c.in[11], 512, 512, (bf16*)(ws + WS_WGLU), scr, r, lane); continue; } r -= I_GLU;
        if (r < I_BA) { p0_transpose_item(c.in[24], 512, 1024, (bf16*)(ws + WS_WBA), scr, r, lane); continue; } r -= I_BA;
        if (r < I_BA) { p0_transpose_item(c.in[24] + 512 * 1024, 512, 1024, (bf16*)(ws + WS_WBB), scr, r, lane); continue; } r -= I_BA;
        if (r < I_OUT) { p0_transpose_item(c.in[25], 1024, 1024, (bf16*)(ws + WS_WOUT), scr, r, lane); continue; } r -= I_OUT;
        if (r < I_1) { p0_transpose_item(c.in[27], 1024, 4096, (bf16*)(ws + WS_W1), scr, r, lane); continue; } r -= I_1;
        p0_transpose_item(c.in[28], 4096, 1024, (bf16*)(ws + WS_W2), scr, r, lane);
    }
    __syncthreads();
}

__device__ __forceinline__ void p0_prologue(const Ctx& c, LAS unsigned char* lds, int vb, int nvb) {
    const int tid = opaque_tid(), lane = tid & 63, wave = tid >> 6;
    LAS float* scr = (LAS float*)(lds + wave * 16384);
    const int gw = vb * NWAVES + wave, NGW = nvb * NWAVES;
    unsigned char* ws = c.ws;
    constexpr int I_INA = 16 * 72, I_L64 = 16, I_L128 = 32;
    constexpr int NITEMS = I_INA + 2 * I_L64 + I_L128;
    for (int it = gw; it < NITEMS; it += NGW) {
        int r = it;
        if (r < I_INA) { p0_transpose_item(c.in[2], 1024, 4352, (bf16*)(ws + WS_WIN), scr, r, lane, 0, 72); continue; } r -= I_INA;
        if (r < I_L64) { p0_transpose_item(c.in[15], 64, 512, (bf16*)(ws + WS_W2T), scr, r, lane); continue; } r -= I_L64;
        if (r < I_L64) { p0_transpose_item(c.in[17], 64, 512, (bf16*)(ws + WS_A2T), scr, r, lane); continue; } r -= I_L64;
        p0_transpose_item(c.in[18], 128, 512, (bf16*)(ws + WS_G2T), scr, r, lane);
    }
    {
        const float* x = c.in[0]; const float* g1 = c.in[1]; bf16* H = (bf16*)(ws + WS_H);
        f4 gv[4];
#pragma unroll
        for (int j = 0; j < 4; ++j) gv[j] = ((const f4*)g1)[lane + 64 * j];
#pragma unroll 4
        for (int m = gw; m < T; m += NGW) {
            const f4* xr = (const f4*)(x + (size_t)m * DM) + lane;
            f4 v[4]; float s = 0.f;
#pragma unroll
            for (int j = 0; j < 4; ++j) { v[j] = xr[64 * j]; s += (v[j].x * v[j].x + v[j].y * v[j].y) + (v[j].z * v[j].z + v[j].w * v[j].w); }
            const float rs = 1.0f / sqrtf(wave_sum(s) * (1.0f / DM) + 1e-6f);
            u2* o = (u2*)(H + (size_t)m * DM) + lane;
#pragma unroll
            for (int j = 0; j < 4; ++j) { f4 w = v[j] * rs * gv[j]; u2 q; q.x = pk2(w.x, w.y); q.y = pk2(w.z, w.w); o[64 * j] = q; }
        }
    }
    const int gt = vb * NTHREADS + tid, NGT = nvb * NTHREADS;
    for (int i = gt; i < 2 * T; i += NGT) ((float*)(ws + WS_ROWSQ1))[i] = 0.f;
    for (int i = gt; i < 32 * 64; i += NGT) {
        const int g = i >> 6, p = i & 63;
        const float lr = fminf(c.in[3][i], -1e-4f), li = c.in[4][i], dt = expf(c.in[5][g]);
        const float mag = expf(lr * dt); float sn, cs; sincosf(li * dt, &sn, &cs);
        const float are = mag * cs, aim = mag * sn;
        const float den = lr * lr + li * li, xm1 = are - 1.0f;
        const float qre = (xm1 * lr + aim * li) / den, qim = (aim * lr - xm1 * li) / den;
        ((f2*)(ws + WS_ABAR))[i] = (f2){are, aim};
        const float magT = expf(lr * dt * (float)S5_TC); float snT, csT; sincosf(li * dt * (float)S5_TC, &snT, &csT);
        ((f2*)(ws + WS_ATC))[i] = (f2){magT * csT, magT * snT};
        float* bb = (float*)(ws + WS_BBAR) + (size_t)i * 32; float* ct = (float*)(ws + WS_CT) + (size_t)i * 32;
        for (int m = 0; m < 16; ++m) {
            const float br = c.in[6][(size_t)i * 16 + m], bi = c.in[7][(size_t)i * 16 + m];
            bb[m] = qre * br - qim * bi; bb[16 + m] = qre * bi + qim * br;
            ((bf16*)(ws + WS_BBT))[(size_t)(g * 128 + p) * 16 + m] = (bf16)f2bf(qre * br - qim * bi); ((bf16*)(ws + WS_BBT))[(size_t)(g * 128 + 64 + p) * 16 + m] = (bf16)f2bf(qre * bi + qim * br);
            ct[m] = c.in[8][(size_t)(g * 16 + m) * 64 + p]; ct[16 + m] = c.in[9][(size_t)(g * 16 + m) * 64 + p];
            ((bf16*)(ws + WS_CTB))[(size_t)(g * 16 + m) * 128 + p] = (bf16)f2bf(c.in[8][(size_t)(g * 16 + m) * 64 + p]); ((bf16*)(ws + WS_CTB))[(size_t)(g * 16 + m) * 128 + 64 + p] = (bf16)f2bf(-c.in[9][(size_t)(g * 16 + m) * 64 + p]);
        }
    }
}

#define EPI_LOOP_BEGIN \
    const int row0 = u.pm * 256 + wr * 64 + fr, colb = u.pn * 256 + wc * 32 + 8 * fq; \
    _Pragma("unroll") for (int ai = 0; ai < 2; ++ai) _Pragma("unroll") for (int m = 0; m < 4; ++m) { const int row = row0 + ai * 128 + m * 16; (void)row;
#define EPI_BJ_BEGIN _Pragma("unroll") for (int bj = 0; bj < 2; ++bj) { const int col = colb + bj * 128; f4 v0 = acc[ai][bj][m][0], v1 = acc[ai][bj][m][1]; (void)col;
#define EPI_END }
typedef pg8::f32x4 AccT[2][2][4][2];

typedef __bf16 bf16x2q __attribute__((ext_vector_type(2)));
__device__ __forceinline__ unsigned cvtpk_q(float lo, float hi) { f2 v = {lo, hi}; bf16x2q b = __builtin_convertvector(v, bf16x2q); return __builtin_bit_cast(unsigned, b); }
__device__ __forceinline__ u4 pack8(f4 a, f4 b) { u4 w; w.x = cvtpk_q(a.x, a.y); w.y = cvtpk_q(a.z, a.w); w.z = cvtpk_q(b.x, b.y); w.w = cvtpk_q(b.z, b.w); return w; }
__device__ __forceinline__ void unpack8(u4 w, f4& a, f4& b) { a = (f4){bflo(w.x), bfhi(w.x), bflo(w.y), bfhi(w.y)}; b = (f4){bflo(w.z), bfhi(w.z), bflo(w.w), bfhi(w.w)}; }
__device__ __forceinline__ f4 sigm4(f4 v) { return (f4){sigm(v.x), sigm(v.y), sigm(v.z), sigm(v.w)}; }

struct EpiProj {
    static constexpr bool PERM = true, AFTER_DRAIN = false; bf16* U; bf16* P;
    __device__ __forceinline__ void operator()(const AccT& acc, const pg8::Unit& u, int wr, int wc, int fr, int fq) const {
        EPI_LOOP_BEGIN EPI_BJ_BEGIN
            if (u.pn < 2) { *(u4*)(U + (size_t)row * DS + col) = pack8(v0, v1); }
            else { *(u4*)(P + (size_t)row * NP + (col - 512)) = pack8(v0, v1); }
        } EPI_END
    }
};
struct EpiGlu {
    static constexpr bool PERM = true, AFTER_DRAIN = false; const bf16* Z; const float* bias; bf16* OA;
    __device__ __forceinline__ void operator()(const AccT& acc, const pg8::Unit& u, int wr, int wc, int fr, int fq) const {
        EPI_LOOP_BEGIN EPI_BJ_BEGIN
            f4 z0, z1; unpack8(*(const u4*)(Z + (size_t)row * DS + col), z0, z1);
            const f4 b0 = *(const f4*)(bias + col), b1 = *(const f4*)(bias + col + 4);
            *(u4*)(OA + (size_t)row * DS + col) = pack8(z0 * sigm4(v0 + b0), z1 * sigm4(v1 + b1));
        } EPI_END
    }
};
struct EpiGateA {
    static constexpr bool PERM = true, AFTER_DRAIN = false; bf16* T1;
    __device__ __forceinline__ void operator()(const AccT& acc, const pg8::Unit& u, int wr, int wc, int fr, int fq) const {
        EPI_LOOP_BEGIN EPI_BJ_BEGIN
            *(u4*)(T1 + (size_t)row * DM + col) = pack8(sigm4(v0), sigm4(v1));
        } EPI_END
    }
};
struct EpiMulA {
    static constexpr bool PERM = true, AFTER_DRAIN = false; bf16* T1;
    __device__ __forceinline__ void operator()(const AccT& acc, const pg8::Unit& u, int wr, int wc, int fr, int fq) const {
        EPI_LOOP_BEGIN EPI_BJ_BEGIN
            bf16* p = T1 + (size_t)row * DM + col; f4 a, b; unpack8(*(const u4*)p, a, b); *(u4*)p = pack8(a * v0, b * v1);
        } EPI_END
    }
};
struct EpiGateB {
    static constexpr bool PERM = true, AFTER_DRAIN = false; bf16* T2;
    __device__ __forceinline__ void operator()(const AccT& acc, const pg8::Unit& u, int wr, int wc, int fr, int fq) const {
        EPI_LOOP_BEGIN EPI_BJ_BEGIN
            *(u4*)(T2 + (size_t)row * DM + col) = pack8(sigm4(v0), sigm4(v1));
        } EPI_END
    }
};
struct EpiMerge {
    static constexpr bool PERM = true, AFTER_DRAIN = false; const bf16* T1; const bf16* T2; bf16* MG;
    __device__ __forceinline__ void operator()(const AccT& acc, const pg8::Unit& u, int wr, int wc, int fr, int fq) const {
        EPI_LOOP_BEGIN EPI_BJ_BEGIN
            f4 a, b; unpack8(*(const u4*)(T1 + (size_t)row * DM + col), a, b);
            f4 g0, g1; unpack8(*(const u4*)(T2 + (size_t)row * DM + col), g0, g1);
            *(u4*)(MG + (size_t)row * DM + col) = pack8(a + g0 * v0, b + g1 * v1);
        } EPI_END
    }
};
struct EpiWout {
    static constexpr bool PERM = true, AFTER_DRAIN = false; const float* x; const float* g2; bf16* X1; bf16* XG; float* rowsq;
    __device__ __forceinline__ void operator()(const AccT& acc, const pg8::Unit& u, int wr, int wc, int fr, int fq) const {
        EPI_LOOP_BEGIN
            float ss = 0.f;
            EPI_BJ_BEGIN
                const float* xp = x + (size_t)row * DM + col; const f4 a = *(const f4*)xp + v0, b = *(const f4*)(xp + 4) + v1;
                const f4 ga = *(const f4*)(g2 + col), gb = *(const f4*)(g2 + col + 4);
                *(u4*)(XG + (size_t)row * DM + col) = pack8(a * ga, b * gb);
                ss += (a.x * a.x + a.y * a.y) + (a.z * a.z + a.w * a.w) + (b.x * b.x + b.y * b.y) + (b.z * b.z + b.w * b.w);
            }
            ss += __shfl_xor(ss, 16); ss += __shfl_xor(ss, 32);
            if (fq == 0) atomicAdd(rowsq + row, ss);
        }
    }
};
struct EpiFF1 {
    static constexpr bool PERM = true, AFTER_DRAIN = false; const float* rowsq; bf16* F;
    __device__ __forceinline__ void operator()(const AccT& acc, const pg8::Unit& u, int wr, int wc, int fr, int fq) const {
        EPI_LOOP_BEGIN
            const float rs = 1.0f / sqrtf(rowsq[row] * (1.0f / DM) + 1e-6f);
            EPI_BJ_BEGIN
                f4 a = v0 * rs, b = v1 * rs;
                a = (f4){fmaxf(a.x, 0.f), fmaxf(a.y, 0.f), fmaxf(a.z, 0.f), fmaxf(a.w, 0.f)}; b = (f4){fmaxf(b.x, 0.f), fmaxf(b.y, 0.f), fmaxf(b.z, 0.f), fmaxf(b.w, 0.f)};
                *(u4*)(F + (size_t)row * DFF + col) = pack8(a * a, b * b);
            }
        }
    }
};
struct EpiFF2 {
    static constexpr bool PERM = true, AFTER_DRAIN = false; bf16* X1; const float* g2; float* rowsq;
    __device__ __forceinline__ void operator()(const AccT& acc, const pg8::Unit& u, int wr, int wc, int fr, int fq) const {
        EPI_LOOP_BEGIN
            float ss = 0.f;
            EPI_BJ_BEGIN
                bf16* xp = X1 + (size_t)row * DM + col; f4 a, b; unpack8(*(const u4*)xp, a, b);
                { const f4 ga = *(const f4*)(g2 + col), gb = *(const f4*)(g2 + col + 4); a = a / ga + v0; b = b / gb + v1; }
                *(u4*)xp = pack8(a, b);
                ss += (a.x * a.x + a.y * a.y) + (a.z * a.z + a.w * a.w) + (b.x * b.x + b.y * b.y) + (b.z * b.z + b.w * b.w);
            }
            ss += __shfl_xor(ss, 16); ss += __shfl_xor(ss, 32);
            if (fq == 0) atomicAdd(rowsq + row, ss);
        }
    }
};

template <class Epi>
__device__ __forceinline__ void run_gemm(LAS unsigned char* lds, const bf16* A, const bf16* Bt, int N, int K, const Epi& E, int vb, int nvb) {
    pg8::Gemm g{A, Bt, T, N, K}; pg8::StaticOrder S; S.init(T, N, nvb, vb);
    pg8::gemm_phase<Epi, pg8::StaticOrder, true, true>(lds, g, S, E);
}

typedef short bf16x8p __attribute__((ext_vector_type(8)));
typedef __bf16 bf16x2p __attribute__((ext_vector_type(2)));
__device__ __forceinline__ unsigned cvtpk_p(float lo, float hi) { f2 v = {lo, hi}; bf16x2p b = __builtin_convertvector(v, bf16x2p); return __builtin_bit_cast(unsigned, b); }
__device__ __forceinline__ u2 pack4p(f4 a) { u2 w; w.x = cvtpk_p(a.x, a.y); w.y = cvtpk_p(a.z, a.w); return w; }
__device__ __forceinline__ f4 unpack4(u2 w) { return (f4){bflo(w.x), bfhi(w.x), bflo(w.y), bfhi(w.y)}; }
__device__ __forceinline__ f4 mfma16p(bf16x8p a, bf16x8p b, f4 c) { return __builtin_amdgcn_mfma_f32_16x16x32_bf16(a, b, c, 0, 0, 0); }
__device__ __forceinline__ void rwkv_prep(const Ctx& c, LAS unsigned char* lds, int vb, int nvb) {
    constexpr int XP = 528;
    const int tid = opaque_tid(), lane = tid & 63, wave = tid >> 6, lr = lane & 15, lq = lane >> 4, h = wave;
    unsigned char* ws = c.ws;
    const bf16* P = (const bf16*)(ws + WS_P);
    const float* mu = c.in[13];
    bf16* Ro = (bf16*)(ws + WS_R); bf16* Ko = (bf16*)(ws + WS_K); bf16* Vo = (bf16*)(ws + WS_V); bf16* KKo = (bf16*)(ws + WS_KK); bf16* Bo = (bf16*)(ws + WS_B);
    float* Wo = (float*)(ws + WS_W); bf16* Go = (bf16*)(ws + WS_G); float* RKo = (float*)(ws + WS_RK);
    const bf16* W2T = (const bf16*)(ws + WS_W2T); const bf16* A2T = (const bf16*)(ws + WS_A2T); const bf16* G2T = (const bf16*)(ws + WS_G2T);
#pragma unroll 1
    for (int tile = vb; tile < T / 32; tile += nvb) {
        const int t0 = tile * 32;
        __syncthreads();
#pragma unroll 4
        for (int i = 0; i < 16; ++i) {
            const int idx = i * 512 + tid, tok = idx >> 8, col = idx & 255, t = t0 + tok, pc = 1536 + col;
            const float p = bf2f(P[(size_t)t * NP + pc]); const float pv = ((t & (SEQ - 1)) == 0) ? 0.f : bf2f(P[(size_t)(t - 1) * NP + pc]);
            const float pm = p + (pv - p) * mu[pc];
            float o; if (col < 128) o = sigm(pm); else if (col < 192) o = tanh_f(pm); else o = pm;
            *(LAS bf16*)(lds + tok * XP + col * 2) = (bf16)f2bf(o);
        }
        __syncthreads();
#pragma unroll 1
        for (int tk = 0; tk < 2; ++tk) {
            f4 aW[4], aA[4], aG[4];
            {
                const LAS unsigned char* xr = lds + (16 * tk + lr) * XP + 16 * lq;
                const bf16x8p bW0 = *(const LAS bf16x8p*)(xr + 256), bW1 = *(const LAS bf16x8p*)(xr + 320), bA0 = *(const LAS bf16x8p*)(xr + 384), bA1 = *(const LAS bf16x8p*)(xr + 448);
                const bf16x8p bG0 = *(const LAS bf16x8p*)(xr), bG1 = *(const LAS bf16x8p*)(xr + 64), bG2 = *(const LAS bf16x8p*)(xr + 128), bG3 = *(const LAS bf16x8p*)(xr + 192);
#pragma unroll
                for (int ct = 0; ct < 4; ++ct) {
                    const int crow = h * 64 + 16 * ct + lr;
                    const bf16x8p fw0 = *(const bf16x8p*)(W2T + crow * 64 + 8 * lq), fw1 = *(const bf16x8p*)(W2T + crow * 64 + 8 * lq + 32);
                    const bf16x8p fa0 = *(const bf16x8p*)(A2T + crow * 64 + 8 * lq), fa1 = *(const bf16x8p*)(A2T + crow * 64 + 8 * lq + 32);
                    const bf16x8p fg0 = *(const bf16x8p*)(G2T + crow * 128 + 8 * lq), fg1 = *(const bf16x8p*)(G2T + crow * 128 + 8 * lq + 32);
                    const bf16x8p fg2 = *(const bf16x8p*)(G2T + crow * 128 + 8 * lq + 64), fg3 = *(const bf16x8p*)(G2T + crow * 128 + 8 * lq + 96);
                    const f4 z = (f4){0.f, 0.f, 0.f, 0.f};
                    aW[ct] = mfma16p(fw1, bW1, mfma16p(fw0, bW0, z));
                    aA[ct] = mfma16p(fa1, bA1, mfma16p(fa0, bA0, z));
                    aG[ct] = mfma16p(fg3, bG3, mfma16p(fg2, bG2, mfma16p(fg1, bG1, mfma16p(fg0, bG0, z))));
                }
            }
            const int t = t0 + 16 * tk + lr; const bool first = (t & (SEQ - 1)) == 0;
            const bf16* pr = P + (size_t)t * NP; const bf16* pp = first ? pr : pr - NP; const float pf = first ? 0.f : 1.f;
            float n2 = 0.f, rk = 0.f; f4 kkv[4], alr[4];
#pragma unroll
            for (int ct = 0; ct < 4; ++ct) {
                const int c0 = h * 64 + 16 * ct + 4 * lq; const size_t o = (size_t)t * DR + c0;
                f4 r = unpack4(*(const u2*)(pr + c0)), k = unpack4(*(const u2*)(pr + 512 + c0)), v = unpack4(*(const u2*)(pr + 1024 + c0));
                const f4 r1 = unpack4(*(const u2*)(pp + c0)) * pf, k1 = unpack4(*(const u2*)(pp + 512 + c0)) * pf, v1 = unpack4(*(const u2*)(pp + 1024 + c0)) * pf;
                r += (r1 - r) * *(const f4*)(mu + c0); k += (k1 - k) * *(const f4*)(mu + 512 + c0); v += (v1 - v) * *(const f4*)(mu + 1024 + c0);
                const f4 al = sigm4(aA[ct] + *(const f4*)(c.in[16] + c0));
                const f4 kv = k * *(const f4*)(c.in[19] + c0);
                n2 += (kv.x * kv.x + kv.y * kv.y) + (kv.z * kv.z + kv.w * kv.w);
                const f4 k2 = k * (1.0f + (al - 1.0f) * *(const f4*)(c.in[20] + c0));
                const f4 rr = r * k2 * *(const f4*)(c.in[21] + c0);
                rk += (rr.x + rr.y) + (rr.z + rr.w);
                *(u2*)(Ro + o) = pack4p(r); *(u2*)(Ko + o) = pack4p(k2); *(u2*)(Vo + o) = pack4p(v);
                const f4 wa = aW[ct] + *(const f4*)(c.in[14] + c0);
                f4 lw;
                { const float z0 = -wa.x, z1 = -wa.y, z2 = -wa.z, z3 = -wa.w;
                  lw.x = -expf(-((z0 > 20.f) ? z0 : log1pf(expf(z0))) - 0.5f); lw.y = -expf(-((z1 > 20.f) ? z1 : log1pf(expf(z1))) - 0.5f);
                  lw.z = -expf(-((z2 > 20.f) ? z2 : log1pf(expf(z2))) - 0.5f); lw.w = -expf(-((z3 > 20.f) ? z3 : log1pf(expf(z3))) - 0.5f); }
                *(f4*)(Wo + o) = lw;
                *(u2*)(Go + o) = pack4p(aG[ct]);
                kkv[ct] = kv; alr[ct] = al;
            }
            n2 += __shfl_xor(n2, 16); n2 += __shfl_xor(n2, 32); rk += __shfl_xor(rk, 16); rk += __shfl_xor(rk, 32);
            const float inv = 1.0f / fmaxf(sqrtf(n2), 1e-12f);
#pragma unroll
            for (int ct = 0; ct < 4; ++ct) {
                const size_t o = (size_t)t * DR + h * 64 + 16 * ct + 4 * lq;
                const f4 kk = kkv[ct] * inv;
                *(u2*)(KKo + o) = pack4p(kk); *(u2*)(Bo + o) = pack4p(kk * alr[ct]);
            }
            if (lq == 0) RKo[t * 8 + h] = rk;
        }
    }
    __syncthreads();
}

constexpr int S5P = 272;
__device__ __forceinline__ void s5_bu_tile(const bf16x8p (&fa)[8], const LAS unsigned char* ub, LAS unsigned char* xs, int sub, int lr, int lq) {
    bf16x8p fb = (bf16x8p){0, 0, 0, 0, 0, 0, 0, 0};
    if (lq < 2) fb = *(const LAS bf16x8p*)(ub + (sub * 16 + lr) * 32 + 16 * lq);
#pragma unroll
    for (int qt = 0; qt < 8; ++qt) {
        const f4 d = mfma16p(fa[qt], fb, (f4){0.f, 0.f, 0.f, 0.f});
        *(LAS u2*)(xs + lr * S5P + (16 * qt + 4 * lq) * 2) = pack4p(d);
    }
}
__device__ __forceinline__ void s5_load_item(const Ctx& c, int g, int tb, int lane, int lr, int lq, bf16x8p (&fa)[8], LAS unsigned char* ub) {
    const bf16* BBT = (const bf16*)(c.ws + WS_BBT);
#pragma unroll
    for (int qt = 0; qt < 8; ++qt) { fa[qt] = (bf16x8p){0, 0, 0, 0, 0, 0, 0, 0}; if (lq < 2) fa[qt] = *(const bf16x8p*)(BBT + (size_t)(g * 128 + 16 * qt + lr) * 16 + 8 * lq); }
    const bf16* U = (const bf16*)((unsigned char*)c.out + DO_U);
    const u4* up = (const u4*)(U + (size_t)(tb + lane) * DS + 16 * g);
    const u4 w0 = up[0], w1 = up[1];
    *(LAS u4*)(ub + lane * 32) = w0; *(LAS u4*)(ub + lane * 32 + 16) = w1;
}
__device__ __forceinline__ void s5_passA(const Ctx& c, LAS unsigned char* lds, int vb, int nvb) {
    const int tid = opaque_tid(), lane = tid & 63, wave = tid >> 6, lr = lane & 15, lq = lane >> 4;
    LAS unsigned char* ub = lds + wave * 6400;
    LAS unsigned char* xs = ub + 2048;
    unsigned char* ws = c.ws;
    const int gw = vb * NWAVES + wave, NGW = nvb * NWAVES;
#pragma unroll 1
    for (int item = gw; item < 2 * 32 * S5_NCH; item += NGW) {
        const int ck = item & (S5_NCH - 1), g = (item >> 7) & 31, b = item >> 12;
        const f2 ab = ((const f2*)(ws + WS_ABAR))[g * 64 + lane];
        bf16x8p fa[8];
        LDS_FENCE();
        s5_load_item(c, g, b * SEQ + ck * S5_TC, lane, lr, lq, fa, ub);
        LDS_FENCE();
        float xr = 0.f, xi = 0.f;
#pragma unroll 1
        for (int sub = 0; sub < 4; ++sub) {
            s5_bu_tile(fa, ub, xs, sub, lr, lq);
            LDS_FENCE();
#pragma unroll
            for (int t = 0; t < 16; ++t) {
                const float br = bf2f(*(const LAS bf16*)(xs + t * S5P + lane * 2)), bi = bf2f(*(const LAS bf16*)(xs + t * S5P + 128 + lane * 2));
                const float nr = ab.x * xr - ab.y * xi + br, ni = ab.x * xi + ab.y * xr + bi; xr = nr; xi = ni;
            }
            LDS_FENCE();
        }
        ((f2*)(ws + WS_E))[(size_t)((b * 32 + g) * S5_NCH + ck) * 64 + lane] = (f2){xr, xi};
    }
}

__device__ __forceinline__ float gelu_tanh(float y) { const float u = 0.7978845608028654f * (y + 0.044715f * y * y * y); return 0.5f * y * (1.0f + tanh_f(u)); }

__device__ __forceinline__ void s5_passC(const Ctx& c, LAS unsigned char* lds, int vb, int nvb) {
    const int tid = opaque_tid(), lane = tid & 63, wave = tid >> 6, lr = lane & 15, lq = lane >> 4;
    LAS unsigned char* ub = lds + wave * 6400;
    LAS unsigned char* xs = ub + 2048;
    unsigned char* ws = c.ws;
    bf16* Z = (bf16*)((unsigned char*)c.out + DO_Z);
    const bf16* CTB = (const bf16*)(ws + WS_CTB);
    const int gw = vb * NWAVES + wave, NGW = nvb * NWAVES;
#pragma unroll 1
    for (int item = gw; item < 2 * 32 * S5_NCH; item += NGW) {
        const int g = item >> 8, bc = item & 255, b = bc >> 7, ck = bc & (S5_NCH - 1), tb = b * SEQ + ck * S5_TC;
        const f2 ab = ((const f2*)(ws + WS_ABAR))[g * 64 + lane], atc = ((const f2*)(ws + WS_ATC))[g * 64 + lane];
        bf16x8p fa[8], fc[4];
#pragma unroll
        for (int ks = 0; ks < 4; ++ks) fc[ks] = *(const bf16x8p*)(CTB + (size_t)(g * 16 + lr) * 128 + 8 * lq + 32 * ks);
        float xr = 0.f, xi = 0.f;
        { const f2* ep = (const f2*)(ws + WS_E) + (size_t)((b * 32 + g) * S5_NCH) * 64 + lane;
          for (int j = 0; j < ck; ++j) { const f2 e = ep[(size_t)j * 64]; const float nr = atc.x * xr - atc.y * xi + e.x, ni = atc.x * xi + atc.y * xr + e.y; xr = nr; xi = ni; } }
        LDS_FENCE();
        s5_load_item(c, g, tb, lane, lr, lq, fa, ub);
        const f4 dv = *(const f4*)(c.in[10] + 16 * g + 4 * lq);
        LDS_FENCE();
#pragma unroll 1
        for (int sub = 0; sub < 4; ++sub) {
            s5_bu_tile(fa, ub, xs, sub, lr, lq);
            LDS_FENCE();
#pragma unroll
            for (int t = 0; t < 16; ++t) {
                LAS bf16* pr = (LAS bf16*)(xs + t * S5P + lane * 2); LAS bf16* pi = (LAS bf16*)(xs + t * S5P + 128 + lane * 2);
                const float br = bf2f(*pr), bi = bf2f(*pi);
                const float nr = ab.x * xr - ab.y * xi + br, ni = ab.x * xi + ab.y * xr + bi; xr = nr; xi = ni;
                *pr = (bf16)f2bf(xr); *pi = (bf16)f2bf(xi);
            }
            LDS_FENCE();
            f4 a = (f4){0.f, 0.f, 0.f, 0.f};
#pragma unroll
            for (int ks = 0; ks < 4; ++ks) a = mfma16p(fc[ks], *(const LAS bf16x8p*)(xs + lr * S5P + 16 * lq + 64 * ks), a);
            const f4 uu = unpack4(*(const LAS u2*)(ub + (sub * 16 + lr) * 32 + 8 * lq));
            const f4 y = a + dv * uu;
            u2 o; o.x = pk2(gelu_tanh(y.x), gelu_tanh(y.y)); o.y = pk2(gelu_tanh(y.z), gelu_tanh(y.w));
            *(u2*)(Z + (size_t)(tb + sub * 16 + lr) * DS + 16 * g + 4 * lq) = o;
            LDS_FENCE();
        }
    }
    __syncthreads();
}

constexpr int TS = 144;
typedef short bf16x8 __attribute__((ext_vector_type(8)));
typedef __bf16 bf16x2_t __attribute__((ext_vector_type(2)));
__device__ __forceinline__ unsigned cvtpk_s(float lo, float hi) { f2 v = {lo, hi}; bf16x2_t b = __builtin_convertvector(v, bf16x2_t); return __builtin_bit_cast(unsigned, b); }
__device__ __forceinline__ u2 pack4(f4 a) { u2 w; w.x = cvtpk_s(a.x, a.y); w.y = cvtpk_s(a.z, a.w); return w; }
__device__ __forceinline__ f4 mfma16(bf16x8 a, bf16x8 b, f4 c) { return __builtin_amdgcn_mfma_f32_16x16x32_bf16(a, b, c, 0, 0, 0); }
__device__ __forceinline__ bf16x8 ldt(const LAS unsigned char* tile, int row, int colb) { return *(const LAS bf16x8*)(tile + row * TS + colb); }

__device__ __forceinline__ void rwkv_pre(const Ctx& c, LAS unsigned char* lds, int vb, int nvb) {
    const int tid = opaque_tid(), lane = tid & 63, wave = tid >> 6, lr = lane & 15, lq = lane >> 4;
    LAS float* LG = (LAS float*)lds;
    LAS unsigned char* tAT = lds + 16384; LAS unsigned char* tBT = tAT + 9216; LAS unsigned char* tKT = tBT + 9216; LAS unsigned char* tRT = tKT + 9216;
    LAS float* NT = (LAS float*)(lds + 53248);
    LAS float* MK = (LAS float*)(lds + 69632);
    unsigned char* ws = c.ws;
    bf16* Ra = (bf16*)(ws + WS_R); bf16* Ka = (bf16*)(ws + WS_K); bf16* KKa = (bf16*)(ws + WS_KK); bf16* Ba = (bf16*)(ws + WS_B); const float* Wa = (const float*)(ws + WS_W);
    bf16* PBT = (bf16*)(ws + WS_PBT); bf16* PKT = (bf16*)(ws + WS_PKT); bf16* MKTT = (bf16*)(ws + WS_MKTT); float* GC = (float*)(ws + WS_GC);
    const int t = tid >> 3, k8 = (tid & 7) * 8;
    f4 pw0, pw1; u4 pkk, pb, pk, pr;
#define PRE_FETCH(task_) do { const int bh_ = (task_) >> 7, ck_ = (task_) & 127; const size_t go_ = (size_t)((bh_ >> 3) * SEQ + ck_ * 64 + t) * DR + (bh_ & 7) * 64 + k8; \
        pw0 = *(const f4*)(Wa + go_); pw1 = *(const f4*)(Wa + go_ + 4); pkk = *(const u4*)(KKa + go_); pb = *(const u4*)(Ba + go_); pk = *(const u4*)(Ka + go_); pr = *(const u4*)(Ra + go_); } while (0)
    if (vb < 2048) PRE_FETCH(vb);
#pragma unroll 1
    for (int task = vb; task < 2048; task += nvb) {
        const int bh = task >> 7, ck = task & 127, b = bh >> 3, hh = bh & 7, t0 = b * SEQ + ck * 64, cb = hh * 64;
        const size_t go = (size_t)(t0 + t) * DR + cb + k8;
        __syncthreads();
        { *(LAS f4*)(LG + t * 64 + k8) = pw0; *(LAS f4*)(LG + t * 64 + k8 + 4) = pw1; }
        __syncthreads();
        if (wave == 0) { float acc = 0.f;
#pragma unroll 16
            for (int i = 0; i < 64; ++i) { acc += LG[i * 64 + lane]; LG[i * 64 + lane] = acc; } }
        __syncthreads();
        {
            f4 kk0, kk1, b0, b1, k0, k1, r0, r1;
            unpack8(pkk, kk0, kk1); unpack8(pb, b0, b1); unpack8(pk, k0, k1); unpack8(pr, r0, r1);
            const f4 lg0 = *(const LAS f4*)(LG + t * 64 + k8), lg1 = *(const LAS f4*)(LG + t * 64 + k8 + 4);
            f4 lm0 = (f4){0.f, 0.f, 0.f, 0.f}, lm1 = lm0;
            if (t > 0) { lm0 = *(const LAS f4*)(LG + (t - 1) * 64 + k8); lm1 = *(const LAS f4*)(LG + (t - 1) * 64 + k8 + 4); }
            const f4 e0 = (f4){__expf(lg0.x), __expf(lg0.y), __expf(lg0.z), __expf(lg0.w)}, e1 = (f4){__expf(lg1.x), __expf(lg1.y), __expf(lg1.z), __expf(lg1.w)};
            const f4 i0 = (f4){__expf(-lg0.x), __expf(-lg0.y), __expf(-lg0.z), __expf(-lg0.w)}, i1 = (f4){__expf(-lg1.x), __expf(-lg1.y), __expf(-lg1.z), __expf(-lg1.w)};
            const f4 m0 = (f4){__expf(lm0.x), __expf(lm0.y), __expf(lm0.z), __expf(lm0.w)}, m1 = (f4){__expf(lm1.x), __expf(lm1.y), __expf(lm1.z), __expf(lm1.w)};
            *(LAS u4*)(tAT + t * TS + k8 * 2) = pack8(-kk0 * m0, -kk1 * m1);
            *(LAS u4*)(tBT + t * TS + k8 * 2) = pack8(b0 * i0, b1 * i1);
            *(LAS u4*)(tKT + t * TS + k8 * 2) = pack8(k0 * i0, k1 * i1);
            const u4 rt = pack8(r0 * e0, r1 * e1);
            *(LAS u4*)(tRT + t * TS + k8 * 2) = rt;
            *(u4*)(Ra + go) = rt;
            if (tid < 64) GC[task * 64 + tid] = __expf(LG[63 * 64 + tid]);
        }
        __syncthreads();
        {
            const int m = wave >> 1, hf = wave & 1;
            const LAS unsigned char* tA = (m & 1) ? tKT : tBT; const LAS unsigned char* tB = (m < 2) ? tAT : tRT;
#pragma unroll
            for (int st2 = 0; st2 < 2; ++st2) {
                const int st = 2 * hf + st2;
                const bf16x8 a0 = ldt(tA, 16 * st + lr, 16 * lq), a1 = ldt(tA, 16 * st + lr, 16 * lq + 64);
#pragma unroll
                for (int tt = 0; tt < 4; ++tt) {
                    const bf16x8 q0 = ldt(tB, 16 * tt + lr, 16 * lq), q1 = ldt(tB, 16 * tt + lr, 16 * lq + 64);
                    f4 acc = mfma16(a0, q0, (f4){0.f, 0.f, 0.f, 0.f}); acc = mfma16(a1, q1, acc);
                    const int sb = 16 * st + 4 * lq, tc = 16 * tt + lr;
                    if (m < 2) { acc.x = (sb + 0 < tc) ? acc.x : 0.f; acc.y = (sb + 1 < tc) ? acc.y : 0.f; acc.z = (sb + 2 < tc) ? acc.z : 0.f; acc.w = (sb + 3 < tc) ? acc.w : 0.f; }
                    else       { acc.x = (sb + 0 <= tc) ? acc.x : 0.f; acc.y = (sb + 1 <= tc) ? acc.y : 0.f; acc.z = (sb + 2 <= tc) ? acc.z : 0.f; acc.w = (sb + 3 <= tc) ? acc.w : 0.f; }
                    if (m == 0) *(LAS f4*)(NT + tc * 64 + sb) = acc;
                    else if (m == 1) { MK[(sb + 0) * 65 + tc] = acc.x; MK[(sb + 1) * 65 + tc] = acc.y; MK[(sb + 2) * 65 + tc] = acc.z; MK[(sb + 3) * 65 + tc] = acc.w; }
                    else if (m == 2) *(u2*)(PBT + (size_t)task * 4096 + tc * 64 + sb) = pack4(acc);
                    else *(u2*)(PKT + (size_t)task * 4096 + tc * 64 + sb) = pack4(acc);
                }
            }
        }
        __syncthreads();
        if (task + nvb < 2048) PRE_FETCH(task + nvb);
        if (wave < 2) {
            float x[64];
            if (wave == 0) {
#pragma unroll
                for (int i = 0; i < 64; ++i) x[i] = bf2f(*(const LAS bf16*)(tAT + i * TS + lane * 2));
            } else {
#pragma unroll
                for (int i = 0; i < 64; ++i) x[i] = MK[lane * 65 + i];
            }
#pragma unroll
            for (int i = 1; i < 64; ++i) {
                float sacc = x[i];
#pragma unroll
                for (int s4 = 0; s4 < (i + 3) / 4; ++s4) { const f4 n = *(const LAS f4*)(NT + i * 64 + 4 * s4); sacc += (x[4 * s4] * n.x + x[4 * s4 + 1] * n.y) + (x[4 * s4 + 2] * n.z + x[4 * s4 + 3] * n.w); }
                x[i] = sacc;
            }
            if (wave == 0) {
#pragma unroll
                for (int i = 0; i < 64; ++i) KKa[(size_t)(t0 + i) * DR + cb + lane] = (bf16)f2bf(x[i]);
            } else {
#pragma unroll
                for (int i = 0; i < 64; ++i) MKTT[(size_t)task * 4096 + i * 64 + lane] = (bf16)f2bf(x[i]);
            }
        } else {
            for (int p = tid - 128; p < 1024; p += 384) {
                const int mat = p >> 9, k = (p >> 3) & 63, s8 = (p & 7) * 8;
                const LAS unsigned char* tile = mat ? tKT : tBT; const float g = __expf(LG[63 * 64 + k]);
                float v[8];
#pragma unroll
                for (int jx = 0; jx < 8; ++jx) v[jx] = bf2f(*(const LAS bf16*)(tile + (s8 + jx) * TS + k * 2)) * g;
                u4 o; o.x = pg8::cvt_pk_bf16(v[0], v[1]); o.y = pg8::cvt_pk_bf16(v[2], v[3]); o.z = pg8::cvt_pk_bf16(v[4], v[5]); o.w = pg8::cvt_pk_bf16(v[6], v[7]);
                *(u4*)((mat ? Ka : Ba) + (size_t)(t0 + k) * DR + cb + s8) = o;
            }
        }
    }
    __syncthreads();
}

__device__ __forceinline__ void rwkv_seq(const Ctx& c, LAS unsigned char* lds, int bh, int vq) {
    const int tid = opaque_tid(), lane = tid & 63, wave = tid >> 6, lr = lane & 15, lq = lane >> 4;
    constexpr int T_AH = 0, T_MK = 9216, T_RT = 18432, T_PB = 27648, T_PK = 36864, T_BH = 46080, T_KH = 55296, T_VT = 64512, GCL = 73728, SB = 74240, UB = 83456;
    unsigned char* ws = c.ws;
    const bf16* Ra = (const bf16*)(ws + WS_R); const bf16* Ka = (const bf16*)(ws + WS_K); const bf16* Va = (const bf16*)(ws + WS_V); const bf16* KKa = (const bf16*)(ws + WS_KK); const bf16* Ba = (const bf16*)(ws + WS_B);
    const bf16* PBT = (const bf16*)(ws + WS_PBT); const bf16* PKT = (const bf16*)(ws + WS_PKT); const bf16* MKTT = (const bf16*)(ws + WS_MKTT); const float* GC = (const float*)(ws + WS_GC);
    float* Y = (float*)(ws + WS_Y);
    const int b = bh >> 3, hh = bh & 7, cb = hh * 64; const size_t tbase = (size_t)b * SEQ;
    const int row = tid >> 3, c8 = (tid & 7) * 8;
    constexpr int YL = 92672;
    const int t128 = tid & 127;
    u4 q0[4], q1[4], q2[4], q3[4], q4[4], q5[4], q6[4], q7[4]; f4 ag = (f4){0.f, 0.f, 0.f, 0.f};
#define RW_ISSUE(ck_) do { _Pragma("unroll") for (int i_ = 0; i_ < 4; ++i_) { const int p_ = t128 + 128 * i_, row_ = p_ >> 3, c8_ = (p_ & 7) * 8; \
        const size_t go_ = (tbase + (size_t)(ck_) * 64 + row_) * DR + cb + c8_; const size_t to_ = (size_t)(bh * 128 + (ck_)) * 4096 + p_ * 8; \
        q0[i_] = *(const u4*)(KKa + go_); q1[i_] = *(const u4*)(MKTT + to_); q2[i_] = *(const u4*)(Ra + go_); q3[i_] = *(const u4*)(PBT + to_); q4[i_] = *(const u4*)(PKT + to_); \
        q5[i_] = *(const u4*)(Ba + go_); q6[i_] = *(const u4*)(Ka + go_); \
        q7[i_] = *(const u4*)(Va + (tbase + (size_t)(ck_) * 64 + (p_ & 63)) * DR + cb + (p_ >> 6) * 8); } \
        if (t128 < 16) ag = *(const f4*)(GC + (size_t)(bh * 128 + (ck_)) * 64 + t128 * 4); } while (0)
#define RW_COMMIT() do { _Pragma("unroll") for (int i_ = 0; i_ < 4; ++i_) { const int p_ = t128 + 128 * i_, row_ = p_ >> 3, c8_ = (p_ & 7) * 8; const int o = row_ * TS + c8_ * 2; \
        *(LAS u4*)(lds + T_AH + o) = q0[i_]; *(LAS u4*)(lds + T_MK + o) = q1[i_]; *(LAS u4*)(lds + T_RT + o) = q2[i_]; *(LAS u4*)(lds + T_PB + o) = q3[i_]; \
        *(LAS u4*)(lds + T_PK + o) = q4[i_]; *(LAS u4*)(lds + T_BH + o) = q5[i_]; *(LAS u4*)(lds + T_KH + o) = q6[i_]; \
        LAS unsigned char* vt = lds + T_VT + ((p_ >> 6) * 8) * TS + (p_ & 63) * 2; const u4 vv_ = q7[i_]; \
        *(LAS bf16*)(vt + 0 * TS) = (bf16)(vv_.x & 0xffffu); *(LAS bf16*)(vt + 1 * TS) = (bf16)(vv_.x >> 16); *(LAS bf16*)(vt + 2 * TS) = (bf16)(vv_.y & 0xffffu); *(LAS bf16*)(vt + 3 * TS) = (bf16)(vv_.y >> 16); \
        *(LAS bf16*)(vt + 4 * TS) = (bf16)(vv_.z & 0xffffu); *(LAS bf16*)(vt + 5 * TS) = (bf16)(vv_.z >> 16); *(LAS bf16*)(vt + 6 * TS) = (bf16)(vv_.w & 0xffffu); *(LAS bf16*)(vt + 7 * TS) = (bf16)(vv_.w >> 16); } \
        if (t128 < 16) *(LAS f4*)(lds + GCL + t128 * 16) = ag; } while (0)
#define RW_YOUT(ck_) do { const LAS float* yl_ = (const LAS float*)(lds + YL + ((ck_) & 1) * 16384); float* yg_ = Y + (tbase + (size_t)(ck_) * 64) * DR + cb; \
        _Pragma("unroll") for (int i_ = 0; i_ < 8; ++i_) { const int e_ = t128 + 128 * i_, tr_ = e_ >> 4, c4_ = (e_ & 15) * 4; *(f4*)(yg_ + (size_t)tr_ * DR + c4_) = *(const LAS f4*)(yl_ + tr_ * 64 + c4_); } } while (0)
    f4 S[4];
#pragma unroll
    for (int i = 0; i < 4; ++i) S[i] = (f4){0.f, 0.f, 0.f, 0.f};
    const int vb = vq * 16;
#define RW_BAR() do { LDS_FENCE(); __builtin_amdgcn_s_barrier(); } while (0)
    if (wave >= 4) {
        const int par = (wave >= 6) ? 1 : 0;
        RW_ISSUE(par);
#pragma unroll 1
        for (int ck = 0; ck < 128; ++ck) {
            RW_BAR();
            if ((ck & 1) == par) { RW_COMMIT();
#ifdef DUP_COMMIT
            LDS_FENCE(); RW_COMMIT();
#endif
            }
            RW_BAR();
            if ((ck & 1) == par && ck + 2 < 128) RW_ISSUE(ck + 2);
        }
        RW_BAR();
    } else if (wave != 0) {
#pragma unroll 1
        for (int ck = 0; ck < 128; ++ck) { RW_BAR(); RW_BAR(); }
        RW_BAR();
    } else {
#pragma unroll 1
        for (int ck = 0; ck < 128; ++ck) {
            RW_BAR(); RW_BAR();
            bf16x8 af[24];
#pragma unroll
            for (int tt = 0; tt < 4; ++tt) { af[4 * tt] = ldt(lds + T_AH, 16 * tt + lr, 16 * lq); af[4 * tt + 1] = ldt(lds + T_AH, 16 * tt + lr, 16 * lq + 64);
                                             af[4 * tt + 2] = ldt(lds + T_MK, 16 * tt + lr, 16 * lq); af[4 * tt + 3] = ldt(lds + T_MK, 16 * tt + lr, 16 * lq + 64); }
            const bf16x8 vt0 = ldt(lds + T_VT, vb + lr, 16 * lq), vt1 = ldt(lds + T_VT, vb + lr, 16 * lq + 64);
#pragma unroll
            for (int kt = 0; kt < 4; ++kt) *(LAS u2*)(lds + SB + (vb + lr) * TS + (16 * kt + 4 * lq) * 2) = pack4(S[kt]);
            const bf16x8 sb0 = ldt(lds + SB, vb + lr, 16 * lq), sb1 = ldt(lds + SB, vb + lr, 16 * lq + 64);
            __builtin_amdgcn_sched_barrier(0);
            f4 u[4];
#pragma unroll
            for (int tt = 0; tt < 4; ++tt) {
                f4 acc = mfma16(af[4 * tt], sb0, (f4){0.f, 0.f, 0.f, 0.f});
                acc = mfma16(af[4 * tt + 1], sb1, acc);
                acc = mfma16(af[4 * tt + 2], vt0, acc);
                acc = mfma16(af[4 * tt + 3], vt1, acc);
                u[tt] = acc;
            }
            __builtin_amdgcn_sched_barrier(0);
#pragma unroll
            for (int tt = 0; tt < 4; ++tt) { af[6 * tt] = ldt(lds + T_RT, 16 * tt + lr, 16 * lq); af[6 * tt + 1] = ldt(lds + T_RT, 16 * tt + lr, 16 * lq + 64);
                                             af[6 * tt + 2] = ldt(lds + T_PB, 16 * tt + lr, 16 * lq); af[6 * tt + 3] = ldt(lds + T_PB, 16 * tt + lr, 16 * lq + 64);
                                             af[6 * tt + 4] = ldt(lds + T_PK, 16 * tt + lr, 16 * lq); af[6 * tt + 5] = ldt(lds + T_PK, 16 * tt + lr, 16 * lq + 64); }
#pragma unroll
            for (int tt = 0; tt < 4; ++tt) *(LAS u2*)(lds + UB + (vb + lr) * TS + (16 * tt + 4 * lq) * 2) = pack4(u[tt]);
            const bf16x8 ub0 = ldt(lds + UB, vb + lr, 16 * lq), ub1 = ldt(lds + UB, vb + lr, 16 * lq + 64);
            __builtin_amdgcn_sched_barrier(0);
            f4 yv[4];
#pragma unroll
            for (int tt = 0; tt < 4; ++tt) {
                f4 acc = mfma16(af[6 * tt], sb0, (f4){0.f, 0.f, 0.f, 0.f});
                acc = mfma16(af[6 * tt + 1], sb1, acc);
                acc = mfma16(af[6 * tt + 2], ub0, acc);
                acc = mfma16(af[6 * tt + 3], ub1, acc);
                acc = mfma16(af[6 * tt + 4], vt0, acc);
                acc = mfma16(af[6 * tt + 5], vt1, acc);
                yv[tt] = acc;
            }
            __builtin_amdgcn_sched_barrier(0);
            f4 gq[4];
#pragma unroll
            for (int kt = 0; kt < 4; ++kt) { af[4 * kt] = ldt(lds + T_BH, 16 * kt + lr, 16 * lq); af[4 * kt + 1] = ldt(lds + T_BH, 16 * kt + lr, 16 * lq + 64);
                                             af[4 * kt + 2] = ldt(lds + T_KH, 16 * kt + lr, 16 * lq); af[4 * kt + 3] = ldt(lds + T_KH, 16 * kt + lr, 16 * lq + 64);
                                             gq[kt] = *(const LAS f4*)(lds + GCL + (16 * kt + 4 * lq) * 4); }
#pragma unroll
            for (int tt = 0; tt < 4; ++tt) { float* yp = Y + (tbase + (size_t)ck * 64 + 16 * tt + 4 * lq) * DR + cb + vb + lr; yp[0] = yv[tt].x; yp[DR] = yv[tt].y; yp[2 * DR] = yv[tt].z; yp[3 * DR] = yv[tt].w; }
            __builtin_amdgcn_sched_barrier(0);
#pragma unroll
            for (int kt = 0; kt < 4; ++kt) {
                f4 acc = S[kt] * gq[kt];
                acc = mfma16(af[4 * kt], ub0, acc);
                acc = mfma16(af[4 * kt + 1], ub1, acc);
                acc = mfma16(af[4 * kt + 2], vt0, acc);
                acc = mfma16(af[4 * kt + 3], vt1, acc);
                S[kt] = acc;
            }
        }
        RW_BAR();
    }
#undef RW_BAR
#undef RW_ISSUE
#undef RW_COMMIT
#undef RW_YOUT
    __syncthreads();
}

__device__ __forceinline__ void rwkv_post(const Ctx& c, int vb, int nvb) {
    const int tid = opaque_tid();
    unsigned char* ws = c.ws;
    const float* Y = (const float*)(ws + WS_Y); const bf16* Va = (const bf16*)(ws + WS_V); const bf16* Ga = (const bf16*)(ws + WS_G); const float* RK = (const float*)(ws + WS_RK);
    bf16* OB = (bf16*)(ws + WS_OB);
#pragma unroll 1
    for (int pair = vb * NTHREADS + tid; pair < T * 8; pair += nvb * NTHREADS) {
        const int h = pair & 7; const size_t o = (size_t)(pair >> 3) * DR + h * 64;
        f4 y[16]; float s1 = 0.f;
#pragma unroll
        for (int i = 0; i < 16; ++i) { y[i] = *(const f4*)(Y + o + 4 * i); s1 += (y[i].x + y[i].y) + (y[i].z + y[i].w); }
        const float mean = s1 * (1.0f / 64.0f); float s2 = 0.f;
#pragma unroll
        for (int i = 0; i < 16; ++i) { y[i] = y[i] - mean; s2 += (y[i].x * y[i].x + y[i].y * y[i].y) + (y[i].z * y[i].z + y[i].w * y[i].w); }
        const float rstd = 1.0f / sqrtf(s2 * (1.0f / 64.0f) + 64e-5f), rk = RK[pair];
#pragma unroll
        for (int i = 0; i < 16; ++i) {
            const f4 lg = *(const f4*)(c.in[22] + h * 64 + 4 * i), lb = *(const f4*)(c.in[23] + h * 64 + 4 * i);
            const f4 v = unpack4(*(const u2*)(Va + o + 4 * i)), g = unpack4(*(const u2*)(Ga + o + 4 * i));
            *(u2*)(OB + o + 4 * i) = pack4p((y[i] * rstd * lg + lb + v * rk) * g);
        }
    }
}

__device__ __forceinline__ void final_norm(const Ctx& c, int vb, int nvb) {
    const int tid = opaque_tid(), lane = tid & 63, wave = tid >> 6;
    const int gw = vb * NWAVES + wave, NGW = nvb * NWAVES;
    const float* rowsq = (const float*)(c.ws + WS_ROWSQ2); const float* gf = c.in[29]; const bf16* X2 = (const bf16*)(c.ws + WS_XG);
    f4 gv[4];
#pragma unroll
    for (int j = 0; j < 2; ++j) { gv[2 * j] = *(const f4*)(gf + 512 * j + 8 * lane); gv[2 * j + 1] = *(const f4*)(gf + 512 * j + 8 * lane + 4); }
#pragma unroll 4
    for (int m = gw; m < T; m += NGW) {
        const float rs = 1.0f / sqrtf(rowsq[m] * (1.0f / DM) + 1e-6f);
        const bf16* xr = X2 + (size_t)m * DM + 8 * lane; float* orow = c.out + (size_t)m * DM + 8 * lane;
#pragma unroll
        for (int j = 0; j < 2; ++j) { f4 a, b; unpack8(*(const u4*)(xr + 512 * j), a, b); *(f4*)(orow + 512 * j) = a * rs * gv[2 * j]; *(f4*)(orow + 512 * j + 4) = b * rs * gv[2 * j + 1]; }
    }
}

__global__ void __launch_bounds__(NTHREADS, 2) mk_fwd(Args args) {
    extern __shared__ __attribute__((aligned(16))) unsigned char lds_raw[];
    LAS unsigned char* lds = (LAS unsigned char*)lds_raw;
    cg::grid_group grid = cg::this_grid();
    Ctx c; c.in = args.in; c.out = args.out; c.ws = args.ws;
    unsigned char* ws = args.ws;
    const int G = gridDim.x, bx = blockIdx.x;
    const int lo = args.ph_lo, hi = args.ph_hi;
#define IN(k) (lo <= (k) && (k) < hi)
#define SEAM(k) do { if (IN(k) && IN((k) + 1)) { if ((k) == 0) grid_barrier_census((unsigned*)(ws + WS_BAR), (unsigned)G, (volatile LAS unsigned*)(lds + 131072)); \
        else grid_barrier_xcd((unsigned*)(ws + WS_BAR), (k), (volatile LAS unsigned*)(lds + 131072)); } } while (0)
    if (args.ph_lo > 1000) grid.sync();
#ifndef REP_P1
#define REP_P1 1
#endif
#ifndef REP_P2
#define REP_P2 1
#endif
#ifndef REP_P3
#define REP_P3 1
#endif
#ifndef REP_P4
#define REP_P4 1
#endif
#ifndef REP_P5
#define REP_P5 1
#endif
#ifndef REP_P7
#define REP_P7 1
#endif
#ifndef REP_P0
#define REP_P0 1
#endif
    bf16* H = (bf16*)(ws + WS_H);

        for (int rep = 0; rep < REP_P0; ++rep) { if (rep) grid.sync();
    if (IN(0)) { p0_prologue(c, lds, bx, G); }
#ifdef DUP_P0
    if (IN(0)) { p0_prologue(c, lds, bx, G); }
#endif
    }
    SEAM(0);
    for (int rep = 0; rep < REP_P1; ++rep) { if (rep) grid.sync();
    if (IN(1)) { EpiProj E{(bf16*)((unsigned char*)args.out + DO_U), (bf16*)(ws + WS_P)}; run_gemm(lds, H, (const bf16*)(ws + WS_WIN), 2304, 1024, E, bx, G);
                 if (bx >= 576 - 2 * G && G > 64) p0_weights_late(c, lds, bx - (576 - 2 * G), G - (576 - 2 * G)); }
#ifdef DUP_P1
    if (IN(1)) { EpiProj E{(bf16*)((unsigned char*)args.out + DO_U), (bf16*)(ws + WS_P)}; run_gemm(lds, H, (const bf16*)(ws + WS_WIN), 2304, 1024, E, bx, G); }
#endif
    }
    SEAM(1);
    if (IN(2)) {
        rwkv_prep(c, lds, bx, G);
        s5_passA(c, lds, bx, G);
    }
#ifdef DUP_PREP
    if (IN(2)) { rwkv_prep(c, lds, bx, G); }
#endif
#ifdef DUP_S5A
    if (IN(2)) { s5_passA(c, lds, bx, G); }
#endif
    SEAM(2);
    if (IN(3)) { rwkv_pre(c, lds, bx, G); }
    SEAM(3);
    for (int rep = 0; rep < REP_P3; ++rep) { if (rep) grid.sync();
    if (IN(4)) {
#ifndef NO_REC
#ifndef REP_SEQ
#define REP_SEQ 1
#endif
        if (bx < NREC) for (int r6 = 0; r6 < REP_SEQ; ++r6) rwkv_seq(c, lds, bx >> 2, bx & 3);
#endif
#ifndef NO_S5C
#ifndef REP_S5C
#define REP_S5C 1
#endif
        if (bx >= NREC) for (int r5 = 0; r5 < REP_S5C; ++r5) s5_passC(c, lds, bx - NREC, G - NREC);
#endif
    }
    }
    SEAM(4);
    for (int rep = 0; rep < REP_P4; ++rep) { if (rep) grid.sync();
    if (IN(5)) {
        EpiGlu E{(const bf16*)((unsigned char*)args.out + DO_Z), args.in[12], (bf16*)((unsigned char*)args.out + DO_OA)};
        run_gemm(lds, (const bf16*)((unsigned char*)args.out + DO_Z), (const bf16*)(ws + WS_WGLU), 512, 512, E, bx, G);
        rwkv_post(c, bx, G);
    }
#ifdef DUP_P5
    if (IN(5)) {
        EpiGlu E{(const bf16*)((unsigned char*)args.out + DO_Z), args.in[12], (bf16*)((unsigned char*)args.out + DO_OA)};
        run_gemm(lds, (const bf16*)((unsigned char*)args.out + DO_Z), (const bf16*)(ws + WS_WGLU), 512, 512, E, bx, G);
        rwkv_post(c, bx, G);
    }
#endif
    }
    SEAM(5);
    for (int rep = 0; rep < REP_P5; ++rep) { if (rep) grid.sync();
    if (IN(6)) {
        { EpiGateA E{(bf16*)(ws + WS_T1)}; run_gemm(lds, H, (const bf16*)(ws + WS_WIN) + (size_t)2304 * 1024, 1024, 1024, E, bx, G); }
        { EpiMulA E{(bf16*)(ws + WS_T1)}; run_gemm(lds, (const bf16*)((unsigned char*)args.out + DO_OA), (const bf16*)(ws + WS_WBA), 1024, 512, E, bx, G); }
        { EpiGateB E{(bf16*)(ws + WS_T2)}; run_gemm(lds, H, (const bf16*)(ws + WS_WIN) + (size_t)3328 * 1024, 1024, 1024, E, bx, G); }
        { EpiMerge E{(const bf16*)(ws + WS_T1), (const bf16*)(ws + WS_T2), (bf16*)(ws + WS_MERGED)}; run_gemm(lds, (const bf16*)(ws + WS_OB), (const bf16*)(ws + WS_WBB), 1024, 512, E, bx, G); }
    }
#ifdef DUP_P6
    if (IN(6)) {
        { EpiGateA E{(bf16*)(ws + WS_T1)}; run_gemm(lds, H, (const bf16*)(ws + WS_WIN) + (size_t)2304 * 1024, 1024, 1024, E, bx, G); }
        { EpiMulA E{(bf16*)(ws + WS_T1)}; run_gemm(lds, (const bf16*)((unsigned char*)args.out + DO_OA), (const bf16*)(ws + WS_WBA), 1024, 512, E, bx, G); }
        { EpiGateB E{(bf16*)(ws + WS_T2)}; run_gemm(lds, H, (const bf16*)(ws + WS_WIN) + (size_t)3328 * 1024, 1024, 1024, E, bx, G); }
        { EpiMerge E{(const bf16*)(ws + WS_T1), (const bf16*)(ws + WS_T2), (bf16*)(ws + WS_MERGED)}; run_gemm(lds, (const bf16*)(ws + WS_OB), (const bf16*)(ws + WS_WBB), 1024, 512, E, bx, G); }
    }
#endif
    }
    SEAM(6);
    if (IN(7)) { EpiWout E{args.in[0], args.in[26], (bf16*)(ws + WS_X1), (bf16*)(ws + WS_XG), (float*)(ws + WS_ROWSQ1)}; run_gemm(lds, (const bf16*)(ws + WS_MERGED), (const bf16*)(ws + WS_WOUT), 1024, 1024, E, bx, G); }
    SEAM(7);
    for (int rep = 0; rep < REP_P7; ++rep) { if (rep) grid.sync();
    if (IN(8)) { EpiFF1 E{(const float*)(ws + WS_ROWSQ1), (bf16*)(ws + WS_F)}; run_gemm(lds, (const bf16*)(ws + WS_XG), (const bf16*)(ws + WS_W1), 4096, 1024, E, bx, G); }
#ifdef DUP_FF1
    if (IN(8)) { EpiFF1 E{(const float*)(ws + WS_ROWSQ1), (bf16*)(ws + WS_F)}; run_gemm(lds, (const bf16*)(ws + WS_XG), (const bf16*)(ws + WS_W1), 4096, 1024, E, bx, G); }
#endif
    }
    SEAM(8);
    if (IN(9)) { EpiFF2 E{(bf16*)(ws + WS_XG), args.in[26], (float*)(ws + WS_ROWSQ2)}; run_gemm(lds, (const bf16*)(ws + WS_F), (const bf16*)(ws + WS_W2), 1024, 4096, E, bx, G); }
    SEAM(9);
    if (IN(10)) { final_norm(c, bx, G); }
#ifdef EXTRA_SYNCS
    for (int i = 0; i < EXTRA_SYNCS; ++i) grid_barrier_xcd((unsigned*)(ws + WS_BAR), 11 + i, (volatile LAS unsigned*)(lds + 131072));
#endif
#undef IN
#undef SEAM
}

extern "C" void kernel_launch(void* const* d_in, const int* in_sizes, int n_in, void* d_out, int out_size, void* d_ws, size_t ws_size, hipStream_t stream) {
    static int grid = 0;
    if (grid == 0) {
        if (n_in != 30 || out_size != T * DM || ws_size < WS_END) { fprintf(stderr, "kernel_launch: unexpected shapes (n_in %d out %d ws %zu)\n", n_in, out_size, ws_size); grid = -1; return; }
        int dev = 0, cus = 0, per_cu = 0;
        hipGetDevice(&dev); hipDeviceGetAttribute(&cus, hipDeviceAttributeMultiprocessorCount, dev);
        if (hipFuncSetAttribute((const void*)mk_fwd, hipFuncAttributeMaxDynamicSharedMemorySize, LDS_BYTES) != hipSuccess) { fprintf(stderr, "kernel_launch: hipFuncSetAttribute failed\n"); grid = -1; return; }
        if (hipOccupancyMaxActiveBlocksPerMultiprocessor(&per_cu, (const void*)mk_fwd, NTHREADS, LDS_BYTES) != hipSuccess || per_cu < 1) { fprintf(stderr, "kernel_launch: occupancy query failed (%d)\n", per_cu); (void)hipGetLastError(); per_cu = 1; }
        grid = cus * (per_cu > 1 ? 1 : per_cu);
        if (grid < 2 * NREC) { fprintf(stderr, "kernel_launch: grid %d too small\n", grid); grid = -1; return; }
    }
    if (grid < 0) return;
    if (hipMemsetAsync((char*)d_ws + WS_BAR, 0, WS_BAR_BYTES, stream) != hipSuccess) { fprintf(stderr, "kernel_launch: memset of the barrier words failed\n"); return; }
    Args a{};
    for (int i = 0; i < 30; ++i) a.in[i] = (const float*)d_in[i];
    a.out = (float*)d_out; a.ws = (unsigned char*)d_ws;
#if MK_LAUNCHES == 1
    a.ph_lo = 0; a.ph_hi = NPHASES;
    void* kargs[] = {&a};
    hipError_t e = hipLaunchCooperativeKernel((const void*)mk_fwd, dim3(grid), dim3(NTHREADS), kargs, LDS_BYTES, stream);
    if (e != hipSuccess) fprintf(stderr, "cooperative launch failed: %s (grid %d)\n", hipGetErrorString(e), grid);
#else
    for (int p = 0; p < NPHASES; ++p) { a.ph_lo = p; a.ph_hi = p + 1; hipLaunchKernelGGL(mk_fwd, dim3(grid), dim3(NTHREADS), LDS_BYTES, stream, a); }
#endif
}
```
